# Optimizing an MI355X kernel written in HIP

```python
import jax
import jax.numpy as jnp
from jax import lax
import numpy as np

D_MODEL = 1024
BATCH = 8
SEQ = 2048
DEPTH = 1

HEAD_DIM = 64
NSA_HEADS = 8
NSA_KV_GROUPS = 2
NSA_CMP_BLOCK = 32
NSA_CMP_STRIDE = 16
NSA_CMP_HIDDEN = 128
NSA_SEL_BLOCK = 64
NSA_SEL_TOPK = 16
NSA_WINDOW = 512
WIN_QBLOCK = 128
NSA_QUERY_CHUNK = 32
MOBA_HEADS = 8
MOBA_BLOCK = 256
MOBA_TOPK = 3
MOBA_QUERY_CHUNK = 16
D_FF = 2816
PLE_DIM = 256
RMS_EPS = 1e-6
NEG_INF = -1e30
TINY = 1e-30
FORCE_SCORE = 1e9

NSA_WIDTH = NSA_HEADS * HEAD_DIM
NSA_KV_WIDTH = NSA_KV_GROUPS * HEAD_DIM
MOBA_WIDTH = MOBA_HEADS * HEAD_DIM
IN_SPLITS = (NSA_WIDTH,) + (NSA_KV_WIDTH,) * 6 + (3 * NSA_HEADS,) + (MOBA_WIDTH,) * 3 + (D_MODEL, D_MODEL)
IN_WIDTH = sum(IN_SPLITS)

kernel_name = "nsa_moba_macaron_hybrid"


def _rmsnorm(x, g):
    xf = x.astype(jnp.float32)
    y = xf * lax.rsqrt(jnp.mean(xf * xf, axis=-1, keepdims=True) + RMS_EPS)
    return (y * g.astype(jnp.float32)).astype(x.dtype)


def _swiglu(x, w1, w3, w2):
    return (jax.nn.silu(x @ w1) * (x @ w3)) @ w2


def _softmax_stats(s, mask):
    s = jnp.where(mask, s.astype(jnp.float32), NEG_INF)
    m = jnp.max(s, axis=-1, keepdims=True)
    e = jnp.where(mask, jnp.exp(s - m), 0.0)
    return e, m, jnp.sum(e, axis=-1, keepdims=True)


def _masked_softmax(s, mask):
    e, _, l = _softmax_stats(s, mask)
    return e / jnp.maximum(l, TINY)


def _alibi_slopes():
    n = NSA_HEADS + MOBA_HEADS
    slopes = jnp.exp2(-8.0 * (jnp.arange(n, dtype=jnp.float32) + 1.0) / n)
    return slopes[0::2], slopes[1::2]


def _nsa_attention(q, k_cmp, v_cmp, k_slc, v_slc, k_win, v_win, gate_logits,
                   cmp_pos_k, cmp_w1_k, cmp_w2_k, cmp_pos_v, cmp_w1_v, cmp_w2_v, slopes):
    B, S = q.shape[0], q.shape[1]
    G, Hg, hd = NSA_KV_GROUPS, NSA_HEADS // NSA_KV_GROUPS, HEAD_DIM
    scale = hd ** -0.5
    qg = q.reshape(B, S, G, Hg, hd).transpose(0, 2, 3, 1, 4)
    k_cmp, v_cmp, k_slc, v_slc, k_win, v_win = [t.transpose(0, 2, 1, 3) for t in
                                                (k_cmp, v_cmp, k_slc, v_slc, k_win, v_win)]
    sl = slopes.reshape(G, Hg)
    t_pos = jnp.arange(S)

    n_c = (S - NSA_CMP_BLOCK) // NSA_CMP_STRIDE + 1
    blk_idx = np.arange(n_c)[:, None] * NSA_CMP_STRIDE + np.arange(NSA_CMP_BLOCK)[None, :]

    def compress(t, pos, w1, w2):
        blocks = t[:, :, blk_idx] + pos
        flat = blocks.reshape(B, G, n_c, NSA_CMP_BLOCK * hd)
        return jax.nn.gelu(flat @ w1) @ w2

    kc = compress(k_cmp, cmp_pos_k, cmp_w1_k, cmp_w2_k)
    vc = compress(v_cmp, cmp_pos_v, cmp_w1_v, cmp_w2_v)
    c_end = jnp.arange(n_c) * NSA_CMP_STRIDE + NSA_CMP_BLOCK - 1
    dist_c = t_pos[:, None] - c_end[None, :]
    s_c = (jnp.einsum('bghtd,bgcd->bghtc', qg, kc).astype(jnp.float32) * scale
           - sl[:, :, None, None] * dist_c.astype(jnp.float32))
    p_c = _masked_softmax(s_c, dist_c >= 0)
    o_cmp = jnp.einsum('bghtc,bgcd->bghtd', p_c.astype(vc.dtype), vc)

    n_sel = S // NSA_SEL_BLOCK
    c_start_np = np.arange(n_c) * NSA_CMP_STRIDE
    c_end_np = c_start_np + NSA_CMP_BLOCK - 1
    s_start_np = np.arange(n_sel) * NSA_SEL_BLOCK
    s_end_np = s_start_np + NSA_SEL_BLOCK - 1
    overlap = ((c_start_np[:, None] <= s_end_np[None, :]) &
               (c_end_np[:, None] >= s_start_np[None, :])).astype(np.float32)
    imp = jnp.einsum('bghtc,cj->bgtj', p_c, jnp.asarray(overlap))
    blk = jnp.arange(n_sel)[None, :]
    cur = (t_pos // NSA_SEL_BLOCK)[:, None]
    causal = blk * NSA_SEL_BLOCK <= t_pos[:, None]
    forced = (blk == 0) | (blk == cur) | (blk == cur - 1)
    imp = jnp.where(causal, jnp.where(forced, FORCE_SCORE, imp), NEG_INF)
    k_top = min(NSA_SEL_TOPK, n_sel)
    _, sel_idx = lax.top_k(imp, k_top)
    k_blk = k_slc.reshape(B, G, n_sel, NSA_SEL_BLOCK, hd)
    v_blk = v_slc.reshape(B, G, n_sel, NSA_SEL_BLOCK, hd)
    C = NSA_QUERY_CHUNK
    nq = S // C
    q_ch = qg.reshape(B, G, Hg, nq, C, hd).transpose(3, 0, 1, 2, 4, 5)
    i_ch = sel_idx.reshape(B, G, nq, C, k_top).transpose(2, 0, 1, 3, 4)
    t_ch = t_pos.reshape(nq, C)
    b_ix = jnp.arange(B)[:, None, None, None]
    g_ix = jnp.arange(G)[None, :, None, None]
    n_keys = k_top * NSA_SEL_BLOCK

    def sel_chunk(args):
        qc, ic, tc = args
        kg = k_blk[b_ix, g_ix, ic].reshape(B, G, C, n_keys, hd)
        vg = v_blk[b_ix, g_ix, ic].reshape(B, G, C, n_keys, hd)
        kpos = (ic[..., None] * NSA_SEL_BLOCK + jnp.arange(NSA_SEL_BLOCK)).reshape(B, G, C, n_keys)
        dist = tc[:, None] - kpos
        s = (jnp.einsum('bghcd,bgcnd->bghcn', qc, kg).astype(jnp.float32) * scale
             - sl[None, :, :, None, None] * dist.astype(jnp.float32)[:, :, None])
        p = _masked_softmax(s, (dist >= 0)[:, :, None])
        return jnp.einsum('bghcn,bgcnd->bghcd', p.astype(vg.dtype), vg)

    o_sel = lax.map(sel_chunk, (q_ch, i_ch, t_ch))
    o_sel = o_sel.transpose(1, 2, 3, 0, 4, 5).reshape(B, G, Hg, S, hd)

    WB = WIN_QBLOCK
    nwb = S // WB
    nw = NSA_WINDOW // WB

    def windows(t):
        tp = jnp.pad(t, ((0, 0), (0, 0), (nw * WB, 0), (0, 0))).reshape(B, G, nwb + nw, WB, hd)
        return jnp.concatenate([tp[:, :, i:i + nwb] for i in range(nw + 1)], axis=3)

    kw = windows(k_win).transpose(2, 0, 1, 3, 4)
    vw = windows(v_win).transpose(2, 0, 1, 3, 4)
    q_blocks = qg.reshape(B, G, Hg, nwb, WB, hd).transpose(3, 0, 1, 2, 4, 5)
    qpos = jnp.arange(nwb)[:, None] * WB + jnp.arange(WB)[None, :]
    kpos_w = jnp.arange(nwb)[:, None] * WB - nw * WB + jnp.arange((nw + 1) * WB)[None, :]

    def win_block(args):
        qb, kb, vb, qp, kp = args
        dist = qp[:, None] - kp[None, :]
        mask = (dist >= 0) & (dist < NSA_WINDOW) & (kp[None, :] >= 0)
        s = (jnp.einsum('bghqd,bgkd->bghqk', qb, kb).astype(jnp.float32) * scale
             - sl[None, :, :, None, None] * dist.astype(jnp.float32))
        p = _masked_softmax(s, mask)
        return jnp.einsum('bghqk,bgkd->bghqd', p.astype(vb.dtype), vb)

    o_win = lax.map(win_block, (q_blocks, kw, vw, qpos, kpos_w))
    o_win = o_win.transpose(1, 2, 3, 0, 4, 5).reshape(B, G, Hg, S, hd)

    g = jax.nn.sigmoid(gate_logits.astype(jnp.float32)).transpose(0, 2, 3, 1, 4)
    o = g[..., 0:1] * o_cmp + g[..., 1:2] * o_sel + g[..., 2:3] * o_win
    return o.transpose(0, 3, 1, 2, 4).reshape(B, S, NSA_WIDTH).astype(q.dtype)


def _moba_attention(q, k, v, slopes):
    B, S, H, hd = q.shape
    L = MOBA_BLOCK
    nb = -(-S // L)
    S_pad = nb * L
    scale = hd ** -0.5
    q, k, v = [jnp.pad(t.transpose(0, 2, 1, 3), ((0, 0), (0, 0), (0, S_pad - S), (0, 0)))
               for t in (q, k, v)]
    t_pos = jnp.arange(S_pad)
    k_blk = k.reshape(B, H, nb, L, hd)
    v_blk = v.reshape(B, H, nb, L, hd)
    q_blk = q.reshape(B, H, nb, L, hd)

    rel = jnp.arange(L)[:, None] - jnp.arange(L)[None, :]
    s_own = (jnp.einsum('bhnqd,bhnkd->bhnqk', q_blk, k_blk).astype(jnp.float32) * scale
             - slopes[None, :, None, None, None] * rel.astype(jnp.float32))
    e_own, m_own, l_own = _softmax_stats(s_own, rel >= 0)
    o_own = jnp.einsum('bhnqk,bhnkd->bhnqd', e_own, v_blk.astype(jnp.float32)).reshape(B, H, S_pad, hd)
    m_own = m_own.reshape(B, H, S_pad, 1)
    l_own = l_own.reshape(B, H, S_pad, 1)

    k_sel = min(MOBA_TOPK, nb - 1)
    if k_sel > 0:
        k_mean = jnp.mean(k_blk.astype(jnp.float32), axis=3)
        gs = jnp.einsum('bhtd,bhnd->bhtn', q.astype(jnp.float32), k_mean)
        cur = t_pos // L
        past = jnp.arange(nb)[None, :] < cur[:, None]
        gs = jnp.where(past, gs, NEG_INF)
        _, idx = lax.top_k(gs, k_sel)
        valid = idx < cur[:, None]
        C = MOBA_QUERY_CHUNK
        nq = S_pad // C
        q_ch = q.reshape(B, H, nq, C, hd).transpose(2, 0, 1, 3, 4)
        i_ch = idx.reshape(B, H, nq, C, k_sel).transpose(2, 0, 1, 3, 4)
        v_ch = valid.reshape(B, H, nq, C, k_sel).transpose(2, 0, 1, 3, 4)
        t_ch = t_pos.reshape(nq, C)
        b_ix = jnp.arange(B)[:, None, None, None]
        h_ix = jnp.arange(H)[None, :, None, None]
        n_keys = k_sel * L

        def sel_chunk(args):
            qc, ic, vc, tc = args
            kg = k_blk[b_ix, h_ix, ic].reshape(B, H, C, n_keys, hd)
            vg = v_blk[b_ix, h_ix, ic].reshape(B, H, C, n_keys, hd)
            kpos = (ic[..., None] * L + jnp.arange(L)).reshape(B, H, C, n_keys)
            mask = jnp.broadcast_to(vc[..., None], (B, H, C, k_sel, L)).reshape(B, H, C, n_keys)
            dist = (tc[:, None] - kpos).astype(jnp.float32)
            s = (jnp.einsum('bhcd,bhcnd->bhcn', qc, kg).astype(jnp.float32) * scale
                 - slopes[None, :, None, None] * dist)
            e, m, l = _softmax_stats(s, mask)
            return jnp.einsum('bhcn,bhcnd->bhcd', e, vg.astype(jnp.float32)), m, l

        o_s, m_s, l_s = lax.map(sel_chunk, (q_ch, i_ch, v_ch, t_ch))
        o_s, m_s, l_s = [a.transpose(1, 2, 0, 3, 4).reshape(B, H, S_pad, a.shape[-1]) for a in (o_s, m_s, l_s)]
        m_tot = jnp.maximum(m_own, m_s)
        a_own = jnp.exp(m_own - m_tot)
        a_s = jnp.exp(m_s - m_tot)
        o = (o_own * a_own + o_s * a_s) / (l_own * a_own + l_s * a_s)
    else:
        o = o_own / l_own
    return o[:, :, :S].transpose(0, 2, 1, 3).reshape(B, S, H * hd).astype(k.dtype)


def _layer(h, p_i, ffn1_norm, ffn1_w1, ffn1_w3, ffn1_w2, mix_norm, w_in,
           cmp_pos_k, cmp_w1_k, cmp_w2_k, cmp_pos_v, cmp_w1_v, cmp_w2_v,
           w_up_nsa, w_up_moba, w_out, ffn2_norm, ffn2_w1, ffn2_w3, ffn2_w2,
           ple_norm, w_ple_gate, w_ple):
    B, S = h.shape[0], h.shape[1]
    h = h + 0.5 * _swiglu(_rmsnorm(h, ffn1_norm), ffn1_w1, ffn1_w3, ffn1_w2)
    u = _rmsnorm(h, mix_norm)
    z = u @ w_in
    offs = np.cumsum((0,) + IN_SPLITS)
    parts = [z[..., int(offs[i]):int(offs[i + 1])] for i in range(len(IN_SPLITS))]
    q_n = parts[0].reshape(B, S, NSA_HEADS, HEAD_DIM)
    kv_n = [t.reshape(B, S, NSA_KV_GROUPS, HEAD_DIM) for t in parts[1:7]]
    g_n = parts[7].reshape(B, S, NSA_KV_GROUPS, NSA_HEADS // NSA_KV_GROUPS, 3)
    q_m, k_m, v_m = [t.reshape(B, S, MOBA_HEADS, HEAD_DIM) for t in parts[8:11]]
    gate_a, gate_b = parts[11], parts[12]
    slopes_n, slopes_m = _alibi_slopes()
    y_n = _nsa_attention(q_n, kv_n[0], kv_n[1], kv_n[2], kv_n[3], kv_n[4], kv_n[5], g_n,
                         cmp_pos_k, cmp_w1_k, cmp_w2_k, cmp_pos_v, cmp_w1_v, cmp_w2_v, slopes_n) @ w_up_nsa
    y_m = _moba_attention(q_m, k_m, v_m, slopes_m) @ w_up_moba
    mixed = jax.nn.sigmoid(gate_a) * y_n + jax.nn.sigmoid(gate_b) * y_m
    h = h + mixed @ w_out
    h = h + 0.5 * _swiglu(_rmsnorm(h, ffn2_norm), ffn2_w1, ffn2_w3, ffn2_w2)
    gate_p = jax.nn.sigmoid(_rmsnorm(h, ple_norm) @ w_ple_gate)
    h = h + gate_p * (p_i @ w_ple).astype(h.dtype)
    return h


def setup_inputs(seed: int = 0) -> dict:
    key = jax.random.key(seed)
    ks = iter(jax.random.split(key, 40))

    def nrm(shape, scale):
        return jax.random.normal(next(ks), shape, jnp.float32) * scale

    def gain(shape):
        return 1.0 + nrm(shape, 0.02)

    L, D, F = DEPTH, D_MODEL, D_FF
    cmp_in = NSA_CMP_BLOCK * HEAD_DIM
    return {
        "x": nrm((BATCH, SEQ, D), 1.0),
        "p": nrm((L, BATCH, SEQ, PLE_DIM), 1.0),
        "ffn1_norm": gain((L, D)),
        "ffn1_w1": nrm((L, D, F), D ** -0.5),
        "ffn1_w3": nrm((L, D, F), D ** -0.5),
        "ffn1_w2": nrm((L, F, D), F ** -0.5),
        "mix_norm": gain((L, D)),
        "w_in": nrm((L, D, IN_WIDTH), D ** -0.5),
        "cmp_pos_k": nrm((L, NSA_CMP_BLOCK, HEAD_DIM), 0.1),
        "cmp_w1_k": nrm((L, cmp_in, NSA_CMP_HIDDEN), cmp_in ** -0.5),
        "cmp_w2_k": nrm((L, NSA_CMP_HIDDEN, HEAD_DIM), NSA_CMP_HIDDEN ** -0.5),
        "cmp_pos_v": nrm((L, NSA_CMP_BLOCK, HEAD_DIM), 0.1),
        "cmp_w1_v": nrm((L, cmp_in, NSA_CMP_HIDDEN), cmp_in ** -0.5),
        "cmp_w2_v": nrm((L, NSA_CMP_HIDDEN, HEAD_DIM), NSA_CMP_HIDDEN ** -0.5),
        "w_up_nsa": nrm((L, NSA_WIDTH, D), NSA_WIDTH ** -0.5),
        "w_up_moba": nrm((L, MOBA_WIDTH, D), MOBA_WIDTH ** -0.5),
        "w_out": nrm((L, D, D), D ** -0.5),
        "ffn2_norm": gain((L, D)),
        "ffn2_w1": nrm((L, D, F), D ** -0.5),
        "ffn2_w3": nrm((L, D, F), D ** -0.5),
        "ffn2_w2": nrm((L, F, D), F ** -0.5),
        "ple_norm": gain((L, D)),
        "w_ple_gate": nrm((L, D, D), D ** -0.5),
        "w_ple": nrm((L, PLE_DIM, D), PLE_DIM ** -0.5),
        "final_norm": gain((D,)),
    }


def reference(x, p, ffn1_norm, ffn1_w1, ffn1_w3, ffn1_w2, mix_norm, w_in,
              cmp_pos_k, cmp_w1_k, cmp_w2_k, cmp_pos_v, cmp_w1_v, cmp_w2_v,
              w_up_nsa, w_up_moba, w_out, ffn2_norm, ffn2_w1, ffn2_w3, ffn2_w2,
              ple_norm, w_ple_gate, w_ple, final_norm):
    h = x
    for i in range(DEPTH):
        h = _layer(h, p[i], ffn1_norm[i], ffn1_w1[i], ffn1_w3[i], ffn1_w2[i], mix_norm[i], w_in[i],
                   cmp_pos_k[i], cmp_w1_k[i], cmp_w2_k[i], cmp_pos_v[i], cmp_w1_v[i], cmp_w2_v[i],
                   w_up_nsa[i], w_up_moba[i], w_out[i], ffn2_norm[i], ffn2_w1[i], ffn2_w3[i], ffn2_w2[i],
                   ple_norm[i], w_ple_gate[i], w_ple[i])
    return _rmsnorm(h, final_norm)
```

```cpp
#include <hip/hip_runtime.h>
#include <cstdint>
#include <cstdio>

namespace {
typedef unsigned short bf16_t;
constexpr int B_ = 8, S_ = 2048, D_ = 1024, M_ = B_ * S_;
constexpr int F_ = 2816, NIN = 4888, NINP = 5120, PLE_ = 256;
constexpr int ZP = NIN;
constexpr int ZC_QN = 0, ZC_KCMP = 512, ZC_VCMP = 640, ZC_KSLC = 768, ZC_VSLC = 896, ZC_KWIN = 1024, ZC_VWIN = 1152,
              ZC_GATE = 1280, ZC_QM = 1304, ZC_KM = 1816, ZC_VM = 2328, ZC_GA = 2840, ZC_GB = 3864;
constexpr float LOG2E = 1.4426950408889634f;
constexpr float C2 = 0.125f * LOG2E;

constexpr size_t MiB = 1u << 20;
constexpr size_t WS_CTL = 0;
constexpr size_t WS_W13A = 1 * MiB;
constexpr size_t SZ_W13 = (size_t)2 * F_ * D_ * 2, SZ_W2 = (size_t)D_ * F_ * 2;
constexpr size_t WS_W2A = WS_W13A + SZ_W13;
constexpr size_t WS_W13B = WS_W2A + SZ_W2;
constexpr size_t WS_W2B = WS_W13B + SZ_W13;
constexpr size_t WS_WIN = WS_W2B + SZ_W2;
constexpr size_t WS_WUPN = WS_WIN + (size_t)NINP * D_ * 2;
constexpr size_t WS_WUPM = WS_WUPN + (size_t)D_ * 512 * 2;
constexpr size_t WS_WOUT = WS_WUPM + (size_t)D_ * 512 * 2;
constexpr size_t WS_WPG = WS_WOUT + (size_t)D_ * D_ * 2;
constexpr size_t WS_WPLE = WS_WPG + (size_t)D_ * D_ * 2;
constexpr size_t WS_WC1K = WS_WPLE + (size_t)D_ * PLE_ * 2;
constexpr size_t WS_WC1V = WS_WC1K + (size_t)128 * 2048 * 2;
constexpr size_t WS_CBIAS = WS_WC1V + (size_t)128 * 2048 * 2;
constexpr size_t WS_KC = WS_CBIAS + 4096;
constexpr size_t WS_VC = WS_KC + (size_t)16 * 128 * 64 * 2;
constexpr size_t WS_KMEAN = WS_VC + (size_t)16 * 128 * 64 * 2;
constexpr size_t WS_SS = WS_KMEAN + (size_t)8 * 8 * 8 * 64 * 4;
constexpr size_t SZ_SS = (size_t)M_ * 16 * 4;
constexpr size_t WS_AB = WS_SS + 5 * SZ_SS;
constexpr size_t WS_PB = WS_AB + (size_t)M_ * D_ * 2;
constexpr size_t WS_R = WS_PB + (size_t)M_ * PLE_ * 2;
constexpr size_t SZ_Z = (size_t)M_ * ZP * 2, SZ_HID = (size_t)M_ * F_ * 2;
constexpr size_t WS_AB2 = WS_R + SZ_HID;
constexpr size_t WS_END = WS_R + SZ_Z;
static_assert(WS_AB2 + (size_t)M_ * D_ * 2 <= WS_END, "AB2 inside R");
static_assert(WS_END <= 256 * MiB, "workspace map must fit 256 MiB");
static_assert((WS_R % 256) == 0 && (WS_AB % 256) == 0 && (WS_KC % 256) == 0 && (WS_SS % 256) == 0, "alignment");

__device__ __forceinline__ float bf2f(bf16_t v) { return __uint_as_float(((unsigned)v) << 16); }
__device__ __forceinline__ float bflo(unsigned u) { return __uint_as_float(u << 16); }
__device__ __forceinline__ float bfhi(unsigned u) { return __uint_as_float(u & 0xffff0000u); }
__device__ __forceinline__ unsigned f2bf(float f) { unsigned u = __float_as_uint(f); return (u + 0x7fffu + ((u >> 16) & 1u)) >> 16; }
__device__ __forceinline__ unsigned pk2(float lo, float hi) { return f2bf(lo) | (f2bf(hi) << 16); }
__device__ __forceinline__ float wsum(float v) {
#pragma unroll
    for (int o = 32; o > 0; o >>= 1) v += __shfl_xor(v, o);
    return v;
}
__device__ __forceinline__ float wmax(float v) {
#pragma unroll
    for (int o = 32; o > 0; o >>= 1) v = fmaxf(v, __shfl_xor(v, o));
    return v;
}
__device__ __forceinline__ float sigmoidf_(float x) { return 1.f / (1.f + __expf(-x)); }
__device__ __forceinline__ float row_rstd(const float* ss, int row) {
    const float4* p = (const float4*)(ss + (size_t)row * 16);
    const float4 a = p[0], b = p[1], c = p[2], d = p[3];
    const float s = ((a.x + a.y) + (a.z + a.w)) + ((b.x + b.y) + (b.z + b.w)) + ((c.x + c.y) + (c.z + c.w)) + ((d.x + d.y) + (d.z + d.w));
    return rsqrtf(s * (1.f / 1024.f) + 1e-6f);
}

struct TrP { const float* W; const float* gain; bf16_t* Wt; int K, N, mode, roff, a0, a1, b0, b1; float sc; int pad; };
static_assert(sizeof(TrP) == 64, "no padding");
__global__ __launch_bounds__(64) void tr_kernel(TrP p) {
    __shared__ float scr[64 * 33];
    const int lane = threadIdx.x, n0 = blockIdx.x * 32, k0 = blockIdx.y * 64;
#pragma unroll 8
    for (int i = 0; i < 32; ++i) {
        const int kk = 2 * i + (lane >> 5), n = n0 + (lane & 31);
        float v = 0.f;
        if (n < p.N) { v = p.W[(size_t)(k0 + kk) * p.N + n]; if (p.gain) v *= p.gain[k0 + kk]; }
        scr[kk * 33 + (lane & 31)] = v;
    }
    __syncthreads();
    const int c = lane & 7;
#pragma unroll
    for (int j = 0; j < 4; ++j) {
        const int nl = (lane >> 3) + 8 * j, n = n0 + nl;
        if (n < p.N) {
            const float* s = scr + (8 * c) * 33 + nl;
            const float sc = ((n >= p.a0 && n < p.a1) || (n >= p.b0 && n < p.b1)) ? p.sc : 1.f;
            uint4 o;
            o.x = pk2(s[0 * 33] * sc, s[1 * 33] * sc); o.y = pk2(s[2 * 33] * sc, s[3 * 33] * sc);
            o.z = pk2(s[4 * 33] * sc, s[5 * 33] * sc); o.w = pk2(s[6 * 33] * sc, s[7 * 33] * sc);
            const int drow = p.mode ? ((n >> 7) * 256 + (n & 127) + p.roff) : (n + p.roff);
            *(uint4*)(p.Wt + (size_t)drow * p.K + k0 + 8 * c) = o;
        }
    }
}
__global__ __launch_bounds__(256) void xprep_kernel(const float* x, bf16_t* xb, float* ss) {
    const int lane = threadIdx.x & 63, row = blockIdx.x * 4 + (threadIdx.x >> 6);
    const float4* xr = (const float4*)(x + (size_t)row * D_) + lane;
    uint2* o = (uint2*)(xb + (size_t)row * D_) + lane;
    float s = 0.f;
#pragma unroll
    for (int j = 0; j < 4; ++j) { const float4 v = xr[64 * j]; s += (v.x * v.x + v.y * v.y) + (v.z * v.z + v.w * v.w); uint2 w; w.x = pk2(v.x, v.y); w.y = pk2(v.z, v.w); o[64 * j] = w; }
    s = wsum(s);
    if (lane < 16) ss[(size_t)row * 16 + lane] = lane == 0 ? s : 0.f;
}
__global__ __launch_bounds__(256) void pprep_kernel(const float* p, bf16_t* pb, int n8) {
    const int i = blockIdx.x * 256 + threadIdx.x;
    if (i < n8) { const float4 a = ((const float4*)p)[2 * i], b = ((const float4*)p)[2 * i + 1]; uint4 o; o.x = pk2(a.x, a.y); o.y = pk2(a.z, a.w); o.z = pk2(b.x, b.y); o.w = pk2(b.z, b.w); ((uint4*)pb)[i] = o; }
}
__global__ __launch_bounds__(128) void cbias_kernel(const float* posk, const float* w1k, const float* posv, const float* w1v, float* bias) {
    const float* pos = blockIdx.x ? posv : posk; const float* w1 = blockIdx.x ? w1v : w1k;
    const int j = threadIdx.x; float s = 0.f;
    for (int i = 0; i < 2048; ++i) s += pos[i] * w1[(size_t)i * 128 + j];
    bias[blockIdx.x * 128 + j] = s;
}

struct GP { const bf16_t* A; const bf16_t* Bt; int lda, ldb, K, bmode, boff, pad; };
static_assert(sizeof(GP) == 40, "no padding");
struct EP { const float* ss; float* outf; const float* resid; bf16_t* outb; float* ssout; const bf16_t* Z; int ldo; float coef; };
static_assert(sizeof(EP) == 56, "no padding");
enum { EPI_SWIGLU = 0, EPI_RES = 1, EPI_INPROJ = 2, EPI_UPMIX = 3, EPI_PLE = 4 };

template <int EPI> __global__ __launch_bounds__(256) void sgemm(GP g1, GP g2, EP e, int N) {
    __shared__ float As[32][68];
    __shared__ float Bs[32][68];
    const int tid = threadIdx.x, tx = tid & 15, ty = tid >> 4, row0 = blockIdx.y * 64, col0 = blockIdx.x * 64;
    float acc1[4][4], acc2[4][4];
#pragma unroll
    for (int i = 0; i < 4; ++i)
#pragma unroll
        for (int j = 0; j < 4; ++j) { acc1[i][j] = 0.f; acc2[i][j] = 0.f; }
    const int lr = tid >> 2, kc = (tid & 3) * 8;
#pragma unroll
    for (int pass = 0; pass < 2; ++pass) {
        const GP& g = pass ? g2 : g1;
        if (g.A == nullptr) continue;
        const int brow0 = g.bmode ? ((col0 >> 7) * 256 + (col0 & 127) + g.boff) : col0;
        for (int k0 = 0; k0 < g.K; k0 += 32) {
            const uint4 va = *(const uint4*)(g.A + (size_t)(row0 + lr) * g.lda + k0 + kc);
            const uint4 vb = *(const uint4*)(g.Bt + (size_t)(brow0 + lr) * g.ldb + k0 + kc);
            __syncthreads();
            As[kc + 0][lr] = bflo(va.x); As[kc + 1][lr] = bfhi(va.x); As[kc + 2][lr] = bflo(va.y); As[kc + 3][lr] = bfhi(va.y);
            As[kc + 4][lr] = bflo(va.z); As[kc + 5][lr] = bfhi(va.z); As[kc + 6][lr] = bflo(va.w); As[kc + 7][lr] = bfhi(va.w);
            Bs[kc + 0][lr] = bflo(vb.x); Bs[kc + 1][lr] = bfhi(vb.x); Bs[kc + 2][lr] = bflo(vb.y); Bs[kc + 3][lr] = bfhi(vb.y);
            Bs[kc + 4][lr] = bflo(vb.z); Bs[kc + 5][lr] = bfhi(vb.z); Bs[kc + 6][lr] = bflo(vb.w); Bs[kc + 7][lr] = bfhi(vb.w);
            __syncthreads();
#pragma unroll 8
            for (int k = 0; k < 32; ++k) {
                const float4 a = *(const float4*)&As[k][ty * 4];
                const float4 b = *(const float4*)&Bs[k][tx * 4];
                const float av[4] = {a.x, a.y, a.z, a.w}, bv[4] = {b.x, b.y, b.z, b.w};
#pragma unroll
                for (int i = 0; i < 4; ++i)
#pragma unroll
                    for (int j = 0; j < 4; ++j) { if (pass) acc2[i][j] += av[i] * bv[j]; else acc1[i][j] += av[i] * bv[j]; }
            }
        }
    }
#pragma unroll
    for (int i = 0; i < 4; ++i) {
        const int row = row0 + ty * 4 + i;
        float rs = 1.f;
        if (EPI == EPI_SWIGLU || EPI == EPI_INPROJ || EPI == EPI_PLE) rs = row_rstd(e.ss, row);
        float sq = 0.f;
#pragma unroll
        for (int j = 0; j < 4; ++j) {
            const int col = col0 + tx * 4 + j;
            if (col >= N) continue;
            const float a1 = acc1[i][j], a2 = acc2[i][j];
            if (EPI == EPI_SWIGLU) {
                const float a = a1 * rs, b = a2 * rs;
                e.outb[(size_t)row * e.ldo + col] = (bf16_t)f2bf(a * sigmoidf_(a) * b);
            } else if (EPI == EPI_RES) {
                const size_t o = (size_t)row * D_ + col;
                const float hv = e.resid[o] + e.coef * a1;
                e.outf[o] = hv; e.outb[o] = (bf16_t)f2bf(hv); sq += hv * hv;
            } else if (EPI == EPI_INPROJ) {
                float v = a1 * rs;
                if ((col >= ZC_GATE && col < ZC_QM) || col >= ZC_GA) v = sigmoidf_(v);
                e.outb[(size_t)row * ZP + col] = (bf16_t)f2bf(v);
            } else if (EPI == EPI_UPMIX) {
                const float sa = bf2f(e.Z[(size_t)row * ZP + ZC_GA + col]), sb = bf2f(e.Z[(size_t)row * ZP + ZC_GB + col]);
                e.outb[(size_t)row * D_ + col] = (bf16_t)f2bf(sa * a1 + sb * a2);
            } else if (EPI == EPI_PLE) {
                const size_t o = (size_t)row * D_ + col;
                const float hv = e.resid[o] + sigmoidf_(a1 * rs) * a2;
                e.outf[o] = hv; sq += hv * hv;
            }
        }
        if (EPI == EPI_RES || EPI == EPI_PLE) {
            sq += __shfl_xor(sq, 1); sq += __shfl_xor(sq, 2); sq += __shfl_xor(sq, 4); sq += __shfl_xor(sq, 8);
            if (tx == 0) e.ssout[(size_t)row * 16 + blockIdx.x] = sq;
        }
    }
}

__global__ __launch_bounds__(256) void final_kernel(float* h, const float* ss, const float* g) {
    const int lane = threadIdx.x & 63, row = blockIdx.x * 4 + (threadIdx.x >> 6);
    const float rs = row_rstd(ss, row);
    float4* hr = (float4*)(h + (size_t)row * D_) + lane; const float4* gr = (const float4*)g + lane;
#pragma unroll
    for (int j = 0; j < 4; ++j) { float4 v = hr[64 * j]; const float4 gg = gr[64 * j]; v.x *= rs * gg.x; v.y *= rs * gg.y; v.z *= rs * gg.z; v.w *= rs * gg.w; hr[64 * j] = v; }
}

__device__ __forceinline__ float gelu_tanh(float x) { const float u = 0.7978845608028654f * (x + 0.044715f * x * x * x); return 0.5f * x * (1.f + tanhf(u)); }
__global__ __launch_bounds__(128) void cmp_kernel(const bf16_t* Z, const bf16_t* w1tk, const bf16_t* w1tv, const float* bias, const float* w2k, const float* w2v, bf16_t* kc, bf16_t* vc) {
    __shared__ float xin[2048];
    __shared__ float hid[128];
    const int c = blockIdx.x, bg = blockIdx.y, kv = blockIdx.z, b = bg >> 1, g = bg & 1, tid = threadIdx.x;
    bf16_t* outc = (kv ? vc : kc) + ((size_t)bg * 128 + c) * 64;
    if (c == 127) { if (tid < 64) outc[tid] = 0; return; }
    const int coloff = (kv ? ZC_VCMP : ZC_KCMP) + g * 64;
    for (int i = tid; i < 2048; i += 128) { const int l = i >> 6, d = i & 63; xin[i] = bf2f(Z[((size_t)b * S_ + 16 * c + l) * ZP + coloff + d]); }
    __syncthreads();
    const bf16_t* w1 = (kv ? w1tv : w1tk) + (size_t)tid * 2048;
    float acc = bias[kv * 128 + tid];
    for (int i = 0; i < 2048; i += 8) {
        const uint4 w = *(const uint4*)(w1 + i);
        acc += xin[i] * bflo(w.x) + xin[i + 1] * bfhi(w.x) + xin[i + 2] * bflo(w.y) + xin[i + 3] * bfhi(w.y) + xin[i + 4] * bflo(w.z) + xin[i + 5] * bfhi(w.z) + xin[i + 6] * bflo(w.w) + xin[i + 7] * bfhi(w.w);
    }
    hid[tid] = gelu_tanh(acc);
    __syncthreads();
    if (tid < 64) { const float* w2 = kv ? w2v : w2k; float s = 0.f; for (int j = 0; j < 128; ++j) s += hid[j] * w2[j * 64 + tid]; outc[tid] = (bf16_t)f2bf(s); }
}
__global__ __launch_bounds__(64) void kmean_kernel(const bf16_t* Z, float* kmean) {
    const int n = blockIdx.x, h = blockIdx.y, b = blockIdx.z, d = threadIdx.x; float s = 0.f;
    for (int i = 0; i < 256; ++i) s += bf2f(Z[((size_t)b * S_ + 256 * n + i) * ZP + ZC_KM + h * 64 + d]);
    kmean[(((size_t)b * 8 + h) * 8 + n) * 64 + d] = s * (1.f / 256.f);
}

__device__ __forceinline__ float dot64(const float* q, const bf16_t* row) {
    const uint4* r = (const uint4*)row; float s = 0.f;
#pragma unroll
    for (int i = 0; i < 8; ++i) { const uint4 v = r[i]; const float* qq = q + 8 * i;
        s += qq[0] * bflo(v.x) + qq[1] * bfhi(v.x) + qq[2] * bflo(v.y) + qq[3] * bfhi(v.y) + qq[4] * bflo(v.z) + qq[5] * bfhi(v.z) + qq[6] * bflo(v.w) + qq[7] * bfhi(v.w); }
    return s;
}
__device__ __forceinline__ void chunk_step(const float* q, const bf16_t* kbase, const bf16_t* vbase, int kpos0, int t, int kmin, float slope2, int lane, float& m, float& l, float& o) {
    const int kpos = kpos0 + lane; const bool ok = kpos <= t && kpos >= kmin;
    float s = -1e30f;
    if (ok) s = dot64(q, kbase + (size_t)lane * ZP) - slope2 * (float)(t - kpos);
    const float mn = fmaxf(m, wmax(s)); const float alpha = exp2f(m - mn); const float p = ok ? exp2f(s - mn) : 0.f;
    l = l * alpha + wsum(p); o *= alpha; m = mn;
    for (int key = 0; key < 64; ++key) { const float pk = __shfl(p, key); if (pk != 0.f) o += pk * bf2f(vbase[(size_t)key * ZP + lane]); }
}

__global__ __launch_bounds__(256) void nsa_kernel(bf16_t* Z, const bf16_t* kc, const bf16_t* vc) {
    __shared__ float q_s[4][64];
    __shared__ float p_s[4][128];
    __shared__ float imp_s[32];
    __shared__ unsigned mask_s;
    const int t = blockIdx.x, g = blockIdx.y, b = blockIdx.z, tid = threadIdx.x, lane = tid & 63, hg = tid >> 6, h = g * 4 + hg, bg = b * 2 + g;
    const size_t row = (size_t)b * S_ + t;
    bf16_t* zrow = Z + row * ZP;
    q_s[hg][lane] = bf2f(zrow[ZC_QN + h * 64 + lane]);
    const float slope2 = exp2f(-(float)(2 * h + 1) * 0.5f) * LOG2E;
    __syncthreads();
    const float* q = q_s[hg];
    const int ncv = t >= 31 ? ((t - 31) >> 4) + 1 : 0;
    const bool ok0 = lane < ncv, ok1 = lane + 64 < ncv;
    float s0 = -1e30f, s1 = -1e30f;
    if (ok0) s0 = dot64(q, kc + ((size_t)bg * 128 + lane) * 64) - slope2 * (float)(t - (16 * lane + 31));
    if (ok1) s1 = dot64(q, kc + ((size_t)bg * 128 + lane + 64) * 64) - slope2 * (float)(t - (16 * (lane + 64) + 31));
    const float mc = wmax(fmaxf(s0, s1));
    const float e0 = ok0 ? exp2f(s0 - mc) : 0.f, e1 = ok1 ? exp2f(s1 - mc) : 0.f;
    const float lc = wsum(e0 + e1), inv = 1.f / fmaxf(lc, 1e-30f);
    p_s[hg][lane] = e0 * inv; p_s[hg][lane + 64] = e1 * inv;
    __syncthreads();
    if (tid < 32) {
        const int j = tid, lo = max(0, 4 * j - 1), hi = min(126, 4 * j + 3); float s = 0.f;
        for (int hh = 0; hh < 4; ++hh) for (int c = lo; c <= hi; ++c) s += p_s[hh][c];
        imp_s[j] = s;
    }
    __syncthreads();
    const int cur = t >> 6;
    if (tid < 64) {
        const int j = lane & 31;
        const bool causal = j <= cur, forced = (j == 0) || (j == cur) || (j == cur - 1);
        const float val = !causal ? -1e30f : (forced ? 1e9f : imp_s[j]);
        int rank = 0;
        for (int jj = 0; jj < 32; ++jj) {
            const bool cj = jj <= cur, fj = (jj == 0) || (jj == cur) || (jj == cur - 1);
            const float vv = !cj ? -1e30f : (fj ? 1e9f : imp_s[jj]);
            rank += (vv > val || (vv == val && jj < j)) ? 1 : 0;
        }
        const unsigned long long bal = __ballot(rank < 16 && causal && lane < 32);
        if (lane == 0) mask_s = (unsigned)bal;
    }
    __syncthreads();
    const unsigned mask = mask_s;
    float oc = 0.f;
    for (int c = 0; c < ncv; ++c) oc += p_s[hg][c] * bf2f(vc[((size_t)bg * 128 + c) * 64 + lane]);
    const bf16_t* zb = Z + (size_t)b * S_ * ZP;
    float ms = -1e30f, ls = 0.f, os = 0.f;
    for (int j = 0; j <= cur; ++j) {
        if (!((mask >> j) & 1u)) continue;
        chunk_step(q, zb + (size_t)(64 * j) * ZP + ZC_KSLC + g * 64, zb + (size_t)(64 * j) * ZP + ZC_VSLC + g * 64, 64 * j, t, 0, slope2, lane, ms, ls, os);
    }
    float mw = -1e30f, lw = 0.f, ow = 0.f;
    const int kmin = max(0, t - 511);
    for (int k0 = kmin & ~63; k0 <= t; k0 += 64)
        chunk_step(q, zb + (size_t)k0 * ZP + ZC_KWIN + g * 64, zb + (size_t)k0 * ZP + ZC_VWIN + g * 64, k0, t, kmin, slope2, lane, mw, lw, ow);
    const float g0 = bf2f(zrow[ZC_GATE + h * 3 + 0]), g1 = bf2f(zrow[ZC_GATE + h * 3 + 1]), g2 = bf2f(zrow[ZC_GATE + h * 3 + 2]);
    const float o = g0 * oc + g1 * (os / ls) + g2 * (ow / lw);
    zrow[ZC_QN + h * 64 + lane] = (bf16_t)f2bf(o);
}

__global__ __launch_bounds__(256) void moba_kernel(bf16_t* Z, const float* kmean) {
    __shared__ float q_s[4][64];
    const int t = blockIdx.x, b = blockIdx.z, tid = threadIdx.x, lane = tid & 63, w = tid >> 6, h = blockIdx.y * 4 + w;
    const size_t row = (size_t)b * S_ + t;
    bf16_t* zrow = Z + row * ZP;
    const float qv = bf2f(zrow[ZC_QM + h * 64 + lane]);
    q_s[w][lane] = qv;
    const float slope2 = exp2f(-(float)(h + 1)) * LOG2E;
    __syncthreads();
    const float* q = q_s[w];
    const int cur = t >> 8;
    float gs[8];
#pragma unroll
    for (int j = 0; j < 8; ++j) { gs[j] = -1e30f; if (j < cur) gs[j] = wsum(qv * kmean[(((size_t)b * 8 + h) * 8 + j) * 64 + lane]); }
    unsigned sel = 0;
#pragma unroll
    for (int j = 0; j < 8; ++j) {
        int rank = 0;
#pragma unroll
        for (int jj = 0; jj < 8; ++jj) rank += (gs[jj] > gs[j] || (gs[jj] == gs[j] && jj < j)) ? 1 : 0;
        if (j < cur && rank < 3) sel |= 1u << j;
    }
    const bf16_t* zb = Z + (size_t)b * S_ * ZP;
    float m = -1e30f, l = 0.f, o = 0.f;
    for (int j = 0; j < cur; ++j) {
        if (!((sel >> j) & 1u)) continue;
        for (int k0 = 256 * j; k0 < 256 * j + 256; k0 += 64)
            chunk_step(q, zb + (size_t)k0 * ZP + ZC_KM + h * 64, zb + (size_t)k0 * ZP + ZC_VM + h * 64, k0, t, 0, slope2, lane, m, l, o);
    }
    for (int k0 = 256 * cur; k0 <= t; k0 += 64)
        chunk_step(q, zb + (size_t)k0 * ZP + ZC_KM + h * 64, zb + (size_t)k0 * ZP + ZC_VM + h * 64, k0, t, 0, slope2, lane, m, l, o);
    zrow[ZC_QM + h * 64 + lane] = (bf16_t)f2bf(o / l);
}
}

extern "C" void kernel_launch(void* const* d_in, const int* in_sizes, int n_in, void* d_out, int out_size, void* d_ws, size_t ws_size, hipStream_t stream) {
    if (n_in != 25 || ws_size < WS_END) { fprintf(stderr, "kernel_launch: unexpected n_in %d / ws_size %zu (need %zu)\n", n_in, ws_size, (size_t)WS_END); return; }
    const float* x = (const float*)d_in[0];
    const float* p = (const float*)d_in[1];
    auto I = [&](int i) { return (const float*)d_in[i]; };
    unsigned char* ws = (unsigned char*)d_ws;
    float* out = (float*)d_out;
    bf16_t* W13A = (bf16_t*)(ws + WS_W13A); bf16_t* W2A = (bf16_t*)(ws + WS_W2A); bf16_t* W13B = (bf16_t*)(ws + WS_W13B); bf16_t* W2B = (bf16_t*)(ws + WS_W2B);
    bf16_t* WIN = (bf16_t*)(ws + WS_WIN); bf16_t* WUPN = (bf16_t*)(ws + WS_WUPN); bf16_t* WUPM = (bf16_t*)(ws + WS_WUPM); bf16_t* WOUT = (bf16_t*)(ws + WS_WOUT);
    bf16_t* WPG = (bf16_t*)(ws + WS_WPG); bf16_t* WPLE = (bf16_t*)(ws + WS_WPLE); bf16_t* WC1K = (bf16_t*)(ws + WS_WC1K); bf16_t* WC1V = (bf16_t*)(ws + WS_WC1V);
    float* CBIAS = (float*)(ws + WS_CBIAS); bf16_t* KC = (bf16_t*)(ws + WS_KC); bf16_t* VC = (bf16_t*)(ws + WS_VC); float* KMEAN = (float*)(ws + WS_KMEAN);
    float* SS1 = (float*)(ws + WS_SS); float* SS2 = (float*)(ws + WS_SS + SZ_SS); float* SS3 = (float*)(ws + WS_SS + 2 * SZ_SS); float* SS4 = (float*)(ws + WS_SS + 3 * SZ_SS); float* SS5 = (float*)(ws + WS_SS + 4 * SZ_SS);
    bf16_t* AB = (bf16_t*)(ws + WS_AB); bf16_t* PB = (bf16_t*)(ws + WS_PB); bf16_t* HID = (bf16_t*)(ws + WS_R); bf16_t* Z = (bf16_t*)(ws + WS_R); bf16_t* AB2 = (bf16_t*)(ws + WS_AB2);

    auto tr = [&](const float* W, const float* gain, bf16_t* Wt, int K, int N, int mode, int roff, int a0, int a1, int b0, int b1, float sc) {
        TrP t{W, gain, Wt, K, N, mode, roff, a0, a1, b0, b1, sc, 0};
        hipLaunchKernelGGL(tr_kernel, dim3((N + 31) / 32, K / 64), dim3(64), 0, stream, t);
    };
    tr(I(3), I(2), W13A, D_, F_, 1, 0, 0, 0, 0, 0, 1.f);
    tr(I(4), I(2), W13A, D_, F_, 1, 128, 0, 0, 0, 0, 1.f);
    tr(I(5), nullptr, W2A, F_, D_, 0, 0, 0, 0, 0, 0, 1.f);
    tr(I(18), I(17), W13B, D_, F_, 1, 0, 0, 0, 0, 0, 1.f);
    tr(I(19), I(17), W13B, D_, F_, 1, 128, 0, 0, 0, 0, 1.f);
    tr(I(20), nullptr, W2B, F_, D_, 0, 0, 0, 0, 0, 0, 1.f);
    tr(I(7), I(6), WIN, D_, NIN, 0, 0, ZC_QN, ZC_QN + 512, ZC_QM, ZC_QM + 512, C2);
    (void)hipMemsetAsync(WIN + (size_t)NIN * D_, 0, (size_t)(NINP - NIN) * D_ * 2, stream);
    tr(I(14), nullptr, WUPN, 512, D_, 0, 0, 0, 0, 0, 0, 1.f);
    tr(I(15), nullptr, WUPM, 512, D_, 0, 0, 0, 0, 0, 0, 1.f);
    tr(I(16), nullptr, WOUT, D_, D_, 0, 0, 0, 0, 0, 0, 1.f);
    tr(I(22), I(21), WPG, D_, D_, 0, 0, 0, 0, 0, 0, 1.f);
    tr(I(23), nullptr, WPLE, PLE_, D_, 0, 0, 0, 0, 0, 0, 1.f);
    tr(I(9), nullptr, WC1K, 2048, 128, 0, 0, 0, 0, 0, 0, 1.f);
    tr(I(12), nullptr, WC1V, 2048, 128, 0, 0, 0, 0, 0, 0, 1.f);
    hipLaunchKernelGGL(cbias_kernel, dim3(2), dim3(128), 0, stream, I(8), I(9), I(11), I(12), CBIAS);
    hipLaunchKernelGGL(xprep_kernel, dim3(M_ / 4), dim3(256), 0, stream, x, AB, SS1);
    hipLaunchKernelGGL(pprep_kernel, dim3(M_ * PLE_ / 8 / 256), dim3(256), 0, stream, p, PB, M_ * PLE_ / 8);

    GP gz{nullptr, nullptr, 0, 0, 0, 0, 0, 0};
    { GP a{AB, W13A, D_, D_, D_, 1, 0, 0}, b{AB, W13A, D_, D_, D_, 1, 128}; EP e{SS1, nullptr, nullptr, HID, nullptr, nullptr, F_, 0.f};
      hipLaunchKernelGGL(sgemm<EPI_SWIGLU>, dim3(F_ / 64, M_ / 64), dim3(256), 0, stream, a, b, e, F_); }
    { GP a{HID, W2A, F_, F_, F_, 0, 0, 0}; EP e{nullptr, out, x, AB, SS2, nullptr, D_, 0.5f};
      hipLaunchKernelGGL(sgemm<EPI_RES>, dim3(D_ / 64, M_ / 64), dim3(256), 0, stream, a, gz, e, D_); }
    { GP a{AB, WIN, D_, D_, D_, 0, 0, 0}; EP e{SS2, nullptr, nullptr, Z, nullptr, nullptr, ZP, 0.f};
      hipLaunchKernelGGL(sgemm<EPI_INPROJ>, dim3((NIN + 63) / 64, M_ / 64), dim3(256), 0, stream, a, gz, e, NIN); }
    hipLaunchKernelGGL(cmp_kernel, dim3(128, 16, 2), dim3(128), 0, stream, Z, WC1K, WC1V, CBIAS, I(10), I(13), KC, VC);
    hipLaunchKernelGGL(kmean_kernel, dim3(8, 8, 8), dim3(64), 0, stream, Z, KMEAN);
    hipLaunchKernelGGL(nsa_kernel, dim3(S_, 2, B_), dim3(256), 0, stream, Z, KC, VC);
    hipLaunchKernelGGL(moba_kernel, dim3(S_, 2, B_), dim3(256), 0, stream, Z, KMEAN);
    { GP a{Z + ZC_QN, WUPN, ZP, 512, 512, 0, 0, 0}, b{Z + ZC_QM, WUPM, ZP, 512, 512, 0, 0}; EP e{nullptr, nullptr, nullptr, AB, nullptr, Z, D_, 0.f};
      hipLaunchKernelGGL(sgemm<EPI_UPMIX>, dim3(D_ / 64, M_ / 64), dim3(256), 0, stream, a, b, e, D_); }
    { GP a{AB, WOUT, D_, D_, D_, 0, 0, 0}; EP e{nullptr, out, out, AB2, SS3, nullptr, D_, 1.0f};
      hipLaunchKernelGGL(sgemm<EPI_RES>, dim3(D_ / 64, M_ / 64), dim3(256), 0, stream, a, gz, e, D_); }
    { GP a{AB2, W13B, D_, D_, D_, 1, 0, 0}, b{AB2, W13B, D_, D_, D_, 1, 128}; EP e{SS3, nullptr, nullptr, HID, nullptr, nullptr, F_, 0.f};
      hipLaunchKernelGGL(sgemm<EPI_SWIGLU>, dim3(F_ / 64, M_ / 64), dim3(256), 0, stream, a, b, e, F_); }
    { GP a{HID, W2B, F_, F_, F_, 0, 0, 0}; EP e{nullptr, out, out, AB, SS4, nullptr, D_, 0.5f};
      hipLaunchKernelGGL(sgemm<EPI_RES>, dim3(D_ / 64, M_ / 64), dim3(256), 0, stream, a, gz, e, D_); }
    { GP a{AB, WPG, D_, D_, D_, 0, 0, 0}, b{PB, WPLE, PLE_, PLE_, PLE_, 0, 0}; EP e{SS4, out, out, nullptr, SS5, nullptr, D_, 0.f};
      hipLaunchKernelGGL(sgemm<EPI_PLE>, dim3(D_ / 64, M_ / 64), dim3(256), 0, stream, a, b, e, D_); }
    hipLaunchKernelGGL(final_kernel, dim3(M_ / 4), dim3(256), 0, stream, out, SS5, I(24));
}
```

```cpp
#include <hip/hip_runtime.h>
#include <cstdint>
#include <cstdio>

#ifndef MK_N_LAUNCHES
#define MK_N_LAUNCHES 1
#endif

namespace {
typedef unsigned short bf16_t;
#define LAS __attribute__((address_space(3)))
#define GAS __attribute__((address_space(1)))
typedef short bf16x8 __attribute__((ext_vector_type(8)));
typedef float f32x4 __attribute__((ext_vector_type(4)));
typedef float f32x16 __attribute__((ext_vector_type(16)));
typedef unsigned u32x4 __attribute__((ext_vector_type(4)));
typedef unsigned u32x2 __attribute__((ext_vector_type(2)));

constexpr int B_ = 8, S_ = 2048, D_ = 1024, M_ = B_ * S_;
constexpr int F_ = 2816, NIN = 4888, NINP = 5120, PLE_ = 256;
constexpr int ZP = NIN;
constexpr int ZC_QN = 0, ZC_KCMP = 512, ZC_VCMP = 640, ZC_KSLC = 768, ZC_VSLC = 896, ZC_KWIN = 1024, ZC_VWIN = 1152,
              ZC_GATE = 1280, ZC_QM = 1304, ZC_KM = 1816, ZC_VM = 2328, ZC_GA = 2840, ZC_GB = 3864;
constexpr float LOG2E = 1.4426950408889634f;
constexpr float C2 = 0.125f * LOG2E;
constexpr int NWAVES = 8, NTHR = 512;

constexpr size_t MiB = 1u << 20;
constexpr size_t WS_CTL = 0, CTL_ZERO_BYTES = 64 * 1024;
constexpr size_t WS_W13A = 1 * MiB;
constexpr size_t SZ_W13 = (size_t)2 * F_ * D_ * 2, SZ_W2 = (size_t)D_ * F_ * 2;
constexpr size_t WS_W2A = WS_W13A + SZ_W13;
constexpr size_t WS_W13B = WS_W2A + SZ_W2;
constexpr size_t WS_W2B = WS_W13B + SZ_W13;
constexpr size_t WS_WIN = WS_W2B + SZ_W2;
constexpr size_t WS_WUPN = WS_WIN + (size_t)NINP * D_ * 2;
constexpr size_t WS_WUPM = WS_WUPN + (size_t)D_ * 512 * 2;
constexpr size_t WS_WOUT = WS_WUPM + (size_t)D_ * 512 * 2;
constexpr size_t WS_WPG = WS_WOUT + (size_t)D_ * D_ * 2;
constexpr size_t WS_WPLE = WS_WPG + (size_t)D_ * D_ * 2;
constexpr size_t WS_WC1K = WS_WPLE + (size_t)D_ * PLE_ * 2;
constexpr size_t WS_WC1V = WS_WC1K + (size_t)128 * 2048 * 2;
constexpr size_t WS_CBIAS = WS_WC1V + (size_t)128 * 2048 * 2;
constexpr size_t WS_KC = WS_CBIAS + 4096;
constexpr size_t WS_VC = WS_KC + (size_t)16 * 128 * 64 * 2;
constexpr size_t WS_KMEAN = WS_VC + (size_t)16 * 128 * 64 * 2;
constexpr size_t WS_SS = WS_KMEAN + (size_t)8 * 8 * 8 * 64 * 4;
constexpr size_t SZ_SS = (size_t)M_ * 16 * 4;
constexpr size_t WS_AB = WS_SS + 5 * SZ_SS;
constexpr size_t WS_PB = WS_AB + (size_t)M_ * D_ * 2;
constexpr size_t WS_R = WS_PB + (size_t)M_ * PLE_ * 2;
constexpr size_t SZ_Z = (size_t)M_ * ZP * 2, SZ_HID = (size_t)M_ * F_ * 2;
constexpr size_t WS_AB2 = WS_R + SZ_HID;
constexpr size_t WS_END = WS_R + SZ_Z;
static_assert(WS_AB2 + (size_t)M_ * D_ * 2 <= WS_END, "AB2 inside R");
static_assert((size_t)M_ * D_ * 4 <= SZ_Z, "pe temp inside R");
static_assert(WS_END <= 256 * MiB, "workspace map must fit 256 MiB");
static_assert((WS_R % 256) == 0 && (WS_AB % 256) == 0 && (WS_KC % 256) == 0 && (WS_SS % 256) == 0, "alignment");

__device__ __forceinline__ float bf2f(bf16_t v) { return __uint_as_float(((unsigned)v) << 16); }
__device__ __forceinline__ float bflo(unsigned u) { return __uint_as_float(u << 16); }
__device__ __forceinline__ float bfhi(unsigned u) { return __uint_as_float(u & 0xffff0000u); }
__device__ __forceinline__ unsigned f2bf(float f) { unsigned u = __float_as_uint(f); return (u + 0x7fffu + ((u >> 16) & 1u)) >> 16; }
__device__ __forceinline__ unsigned pk2(float lo, float hi) { return f2bf(lo) | (f2bf(hi) << 16); }
typedef float f32x2_t __attribute__((ext_vector_type(2)));
typedef __bf16 bf16x2_t __attribute__((ext_vector_type(2)));
__device__ __forceinline__ unsigned cvtpk(float lo, float hi) { f32x2_t v = {lo, hi}; bf16x2_t b = __builtin_convertvector(v, bf16x2_t); return __builtin_bit_cast(unsigned, b); }
__device__ __forceinline__ float wsum(float v) {
#pragma unroll
    for (int o = 32; o > 0; o >>= 1) v += __shfl_xor(v, o);
    return v;
}
__device__ __forceinline__ float wmax(float v) {
#pragma unroll
    for (int o = 32; o > 0; o >>= 1) v = fmaxf(v, __shfl_xor(v, o));
    return v;
}
__device__ __forceinline__ float fsigmoid(float x) { return __builtin_amdgcn_rcpf(1.f + __builtin_amdgcn_exp2f(-LOG2E * x)); }
namespace pg8 {
constexpr int BM = 256, BK = 64, HALF = 128, HTB = HALF * BK * 2  , STAGE_BYTES = 8 * HTB, NXCD = 8, WGM = 8;
__host__ __device__ __forceinline__ int lds_byte(int r, int c) { const int st = (r >> 4) * 2 + (c >> 5), rr = r & 15, cc = c & 31, ob = rr * 64 + cc * 2; return st * 1024 + (ob ^ (((ob >> 9) & 1) << 5)); }
__host__ __device__ __forceinline__ void stage_rc(int b, int& R, int& C) { const int st = b / 1024, sb = b % 1024, swz = sb ^ (((sb >> 9) & 1) << 5); R = (st >> 1) * 16 + swz / 64; C = (st & 1) * 32 + (swz % 64) / 2; }
__host__ __device__ __forceinline__ int perm32(int rho) { const int n = rho >> 4, i = rho & 15; return 8 * (i >> 2) + 4 * n + (i & 3); }

struct Unit { int pm, pn; };
struct Gemm { const bf16_t* A; const bf16_t* Bt; int lda, ldb, M, N, K; };

struct StaticOrder {
    int nM, nN, nwg, G, c;
    __host__ __device__ void init(int M, int N, int G_, int c_) { nM = M / BM; nN = N / BM; nwg = nM * nN; G = G_; c = c_; }
    __host__ __device__ bool next(int i, Unit& u) const {
        const long L = (long)i * G + c; if (L >= nwg) return false;
        int wgid = (int)L; { const int q = nwg / NXCD, r = nwg % NXCD, xcd = wgid % NXCD, off = wgid / NXCD; wgid = (xcd < r ? xcd * (q + 1) : r * (q + 1) + (xcd - r) * q) + off; }
        const int nig = WGM * nN, gid = wgid / nig, fm = gid * WGM, gsz = (nM - fm) < WGM ? (nM - fm) : WGM;
        u.pm = fm + ((wgid % nig) % gsz); u.pn = (wgid % nig) / gsz; return true;
    }
};

__device__ __forceinline__ float rs_from_ss(const float* ss, int row, int fq) {
    const f32x4 v = *(const f32x4*)(ss + (size_t)row * 16 + 4 * fq);
    float s = (v[0] + v[1]) + (v[2] + v[3]); s += __shfl_xor(s, 16); s += __shfl_xor(s, 32);
    return rsqrtf(s * (1.f / 1024.f) + 1e-6f);
}
__device__ __forceinline__ u32x4 pack8(const f32x4& a, const f32x4& b) { u32x4 w; w.x = cvtpk(a[0], a[1]); w.y = cvtpk(a[2], a[3]); w.z = cvtpk(b[0], b[1]); w.w = cvtpk(b[2], b[3]); return w; }

struct EpiSwiglu {
    static constexpr bool PERM = true;
    const float* ss; bf16_t* hid;
    __device__ __forceinline__ void operator()(const f32x4 (&acc)[2][2][4][2], const Unit& u, int wr, int wc, int fr, int fq) const {
        const int row0 = u.pm * BM + wr * 64 + fr, col0 = u.pn * 128 + wc * 32 + 8 * fq;
#pragma unroll
        for (int ai = 0; ai < 2; ++ai)
#pragma unroll
            for (int m = 0; m < 4; ++m) {
                const int row = row0 + ai * HALF + m * 16; const float rs = rs_from_ss(ss, row, fq);
                f32x4 h[2];
#pragma unroll
                for (int n = 0; n < 2; ++n) { const f32x4 a = acc[ai][0][m][n] * rs, b = acc[ai][1][m][n] * rs;
#pragma unroll
                    for (int i = 0; i < 4; ++i) h[n][i] = a[i] * b[i] * fsigmoid(a[i]); }
                *(u32x4*)(hid + (size_t)row * F_ + col0) = pack8(h[0], h[1]);
            }
    }
};
struct EpiRes {
    static constexpr bool PERM = true;
    const float* resid; float* outf; bf16_t* outb; float* ssout; float coef;
    __device__ __forceinline__ void operator()(const f32x4 (&acc)[2][2][4][2], const Unit& u, int wr, int wc, int fr, int fq) const {
        const int row0 = u.pm * BM + wr * 64 + fr, col0 = u.pn * BM + wc * 32 + 8 * fq;
#pragma unroll
        for (int ai = 0; ai < 2; ++ai)
#pragma unroll
            for (int m = 0; m < 4; ++m) {
                const int row = row0 + ai * HALF + m * 16; float sq = 0.f;
#pragma unroll
                for (int bj = 0; bj < 2; ++bj) {
                    const size_t off = (size_t)row * D_ + col0 + bj * HALF;
                    const f32x4 r0 = *(const f32x4*)(resid + off), r1 = *(const f32x4*)(resid + off + 4);
                    const f32x4 v0 = r0 + acc[ai][bj][m][0] * coef, v1 = r1 + acc[ai][bj][m][1] * coef;
                    *(f32x4*)(outf + off) = v0; *(f32x4*)(outf + off + 4) = v1;
                    *(u32x4*)(outb + off) = pack8(v0, v1);
                    sq += (v0[0] * v0[0] + v0[1] * v0[1]) + (v0[2] * v0[2] + v0[3] * v0[3]) + (v1[0] * v1[0] + v1[1] * v1[1]) + (v1[2] * v1[2] + v1[3] * v1[3]);
                }
                sq += __shfl_xor(sq, 16); sq += __shfl_xor(sq, 32);
                if (fq == 0) ssout[(size_t)row * 16 + u.pn * 4 + wc] = sq;
            }
    }
};
struct EpiInproj {
    static constexpr bool PERM = true;
    const float* ss; bf16_t* Z;
    __device__ __forceinline__ void operator()(const f32x4 (&acc)[2][2][4][2], const Unit& u, int wr, int wc, int fr, int fq) const {
        const int row0 = u.pm * BM + wr * 64 + fr, col0 = u.pn * BM + wc * 32 + 8 * fq;
#pragma unroll
        for (int ai = 0; ai < 2; ++ai)
#pragma unroll
            for (int m = 0; m < 4; ++m) {
                const int row = row0 + ai * HALF + m * 16; const float rs = rs_from_ss(ss, row, fq);
#pragma unroll
                for (int bj = 0; bj < 2; ++bj) {
                    const int col = col0 + bj * HALF;
                    if (col < NIN) {
                        f32x4 v0 = acc[ai][bj][m][0] * rs, v1 = acc[ai][bj][m][1] * rs;
                        if ((col >= ZC_GATE && col < ZC_QM) || col >= ZC_GA) {
#pragma unroll
                            for (int i = 0; i < 4; ++i) { v0[i] = fsigmoid(v0[i]); v1[i] = fsigmoid(v1[i]); }
                        }
                        *(u32x4*)(Z + (size_t)row * ZP + col) = pack8(v0, v1);
                    }
                }
            }
    }
};
template <int PASS> struct EpiUpmix {
    static constexpr bool PERM = true;
    const bf16_t* Z; bf16_t* outb;
    __device__ __forceinline__ void operator()(const f32x4 (&acc)[2][2][4][2], const Unit& u, int wr, int wc, int fr, int fq) const {
        const int row0 = u.pm * BM + wr * 64 + fr, col0 = u.pn * BM + wc * 32 + 8 * fq;
#pragma unroll
        for (int ai = 0; ai < 2; ++ai)
#pragma unroll
            for (int m = 0; m < 4; ++m) {
                const int row = row0 + ai * HALF + m * 16;
#pragma unroll
                for (int bj = 0; bj < 2; ++bj) {
                    const int col = col0 + bj * HALF;
                    const u32x4 gw = *(const u32x4*)(Z + (size_t)row * ZP + (PASS ? ZC_GB : ZC_GA) + col);
                    f32x4 v0, v1;
                    v0[0] = bflo(gw.x) * acc[ai][bj][m][0][0]; v0[1] = bfhi(gw.x) * acc[ai][bj][m][0][1]; v0[2] = bflo(gw.y) * acc[ai][bj][m][0][2]; v0[3] = bfhi(gw.y) * acc[ai][bj][m][0][3];
                    v1[0] = bflo(gw.z) * acc[ai][bj][m][1][0]; v1[1] = bfhi(gw.z) * acc[ai][bj][m][1][1]; v1[2] = bflo(gw.w) * acc[ai][bj][m][1][2]; v1[3] = bfhi(gw.w) * acc[ai][bj][m][1][3];
                    bf16_t* o = outb + (size_t)row * D_ + col;
                    if (PASS) { const u32x4 t = *(const u32x4*)o;
                        v0[0] += bflo(t.x); v0[1] += bfhi(t.x); v0[2] += bflo(t.y); v0[3] += bfhi(t.y); v1[0] += bflo(t.z); v1[1] += bfhi(t.z); v1[2] += bflo(t.w); v1[3] += bfhi(t.w); }
                    *(u32x4*)o = pack8(v0, v1);
                }
            }
    }
};
struct EpiPe {
    static constexpr bool PERM = true;
    float* pe;
    __device__ __forceinline__ void operator()(const f32x4 (&acc)[2][2][4][2], const Unit& u, int wr, int wc, int fr, int fq) const {
        const int row0 = u.pm * BM + wr * 64 + fr, col0 = u.pn * BM + wc * 32 + 8 * fq;
#pragma unroll
        for (int ai = 0; ai < 2; ++ai)
#pragma unroll
            for (int m = 0; m < 4; ++m)
#pragma unroll
                for (int bj = 0; bj < 2; ++bj) { const size_t off = (size_t)(row0 + ai * HALF + m * 16) * D_ + col0 + bj * HALF;
                    *(f32x4*)(pe + off) = acc[ai][bj][m][0]; *(f32x4*)(pe + off + 4) = acc[ai][bj][m][1]; }
    }
};
struct EpiPle {
    static constexpr bool PERM = true;
    const float* ss; const float* pe; float* h; float* ssout;
    __device__ __forceinline__ void operator()(const f32x4 (&acc)[2][2][4][2], const Unit& u, int wr, int wc, int fr, int fq) const {
        const int row0 = u.pm * BM + wr * 64 + fr, col0 = u.pn * BM + wc * 32 + 8 * fq;
#pragma unroll
        for (int ai = 0; ai < 2; ++ai)
#pragma unroll
            for (int m = 0; m < 4; ++m) {
                const int row = row0 + ai * HALF + m * 16; const float rs = rs_from_ss(ss, row, fq); float sq = 0.f;
#pragma unroll
                for (int bj = 0; bj < 2; ++bj) {
                    const size_t off = (size_t)row * D_ + col0 + bj * HALF;
#pragma unroll
                    for (int n = 0; n < 2; ++n) {
                        const f32x4 r = *(const f32x4*)(h + off + 4 * n), p = *(const f32x4*)(pe + off + 4 * n); f32x4 v;
#pragma unroll
                        for (int i = 0; i < 4; ++i) { v[i] = r[i] + fsigmoid(acc[ai][bj][m][n][i] * rs) * p[i]; sq += v[i] * v[i]; }
                        *(f32x4*)(h + off + 4 * n) = v;
                    }
                }
                sq += __shfl_xor(sq, 16); sq += __shfl_xor(sq, 32);
                if (fq == 0) ssout[(size_t)row * 16 + u.pn * 4 + wc] = sq;
            }
    }
};

template <class Epi, class Sched, bool ALIGN_EPI>
__device__ __forceinline__ void gemm_phase(LAS unsigned char* lds, const Gemm g, const Sched& S, const Epi& E) {
    const int tid = threadIdx.x, wid = __builtin_amdgcn_readfirstlane(tid >> 6), lane = tid & 63, wr = wid >> 2, wc = wid & 3, fr = lane & 15, fq = lane >> 4;
    const int K = g.K, nt = K / BK;
    unsigned voffA[2], voffB[2];
#pragma unroll
    for (int i = 0; i < 2; ++i) { int R, C; stage_rc(tid * 16 + i * 8192, R, C); const int Rb = Epi::PERM ? ((R & ~31) + perm32(R & 31)) : R;
        voffA[i] = (unsigned)(R * g.lda + C) * 2u; voffB[i] = (unsigned)(Rb * g.ldb + C) * 2u; }
    const size_t kstep = (size_t)(BK * 2);
    const size_t hstepA = (size_t)HALF * g.lda * 2, hstepB = (size_t)HALF * g.ldb * 2;
    const size_t tstepA = 2 * hstepA, tstepB = 2 * hstepB;
    const unsigned ldsw = (unsigned)wid * 1024u;
    const int aoff = lds_byte(wr * 64 + fr, fq * 8), boff = lds_byte(wc * 32 + fr, fq * 8);
#define PG8_SA(b, h) (((b) * 2 + (h)) * HTB)
#define PG8_SB(b, h) ((4 + (b) * 2 + (h)) * HTB)
#define PG8_STAGE(bufoff, gbase, voff) do { _Pragma("unroll") for (int _i = 0; _i < 2; ++_i) \
        __builtin_amdgcn_global_load_lds((const unsigned*)((const char*)(gbase) + (voff)[_i]), (LAS unsigned*)(lds + (bufoff) + ldsw + _i * 8192), 16, 0, 0); } while (0)
#define PG8_LDA(dst, b, h) do { _Pragma("unroll") for (int m = 0; m < 4; ++m) _Pragma("unroll") for (int k = 0; k < 2; ++k) dst[m][k] = *(const LAS bf16x8*)(lds + PG8_SA(b, h) + aoff + m * 2048 + k * 1024); } while (0)
#define PG8_LDB(dst, b, h) do { _Pragma("unroll") for (int n = 0; n < 2; ++n) _Pragma("unroll") for (int k = 0; k < 2; ++k) dst[n][k] = *(const LAS bf16x8*)(lds + PG8_SB(b, h) + boff + n * 2048 + k * 1024); } while (0)
#define PG8_MMA(ai, bj, At, Bt) do { __builtin_amdgcn_s_setprio(1); _Pragma("unroll") for (int m = 0; m < 4; ++m) _Pragma("unroll") for (int n = 0; n < 2; ++n) _Pragma("unroll") for (int k = 0; k < 2; ++k) \
        acc[ai][bj][m][n] = __builtin_amdgcn_mfma_f32_16x16x32_bf16(Bt[n][k], At[m][k], acc[ai][bj][m][n], 0, 0, 0); __builtin_amdgcn_s_setprio(0); } while (0)
#define PG8_WAIT_V(n) asm volatile("s_waitcnt vmcnt(" #n ")" ::: "memory")
#define PG8_WAIT_L(n) asm volatile("s_waitcnt lgkmcnt(" #n ")" ::: "memory")
#define PG8_BAR __builtin_amdgcn_s_barrier()
#define PG8_SCHED __builtin_amdgcn_sched_barrier(0)
    Unit cur, nxt; int ui = 0;
    if (!S.next(0, cur)) return;
    f32x4 acc[2][2][4][2];
#pragma unroll
    for (int a = 0; a < 2; ++a)
#pragma unroll
        for (int b = 0; b < 2; ++b)
#pragma unroll
            for (int m = 0; m < 4; ++m)
#pragma unroll
                for (int n = 0; n < 2; ++n) acc[a][b][m][n] = (f32x4){0.f, 0.f, 0.f, 0.f};
    bf16x8 At[4][2], B0[2][2], B1[2][2];
    const char* cA = (const char*)g.A + (size_t)cur.pm * tstepA; const char* cB = (const char*)g.Bt + (size_t)cur.pn * tstepB;
    PG8_STAGE(PG8_SB(0, 0), cB, voffB); PG8_STAGE(PG8_SB(0, 1), cB + hstepB, voffB); PG8_STAGE(PG8_SA(0, 0), cA, voffA); PG8_STAGE(PG8_SA(0, 1), cA + hstepA, voffA);
    if (wr == 1) PG8_BAR;
    PG8_WAIT_V(2); PG8_BAR;
    PG8_STAGE(PG8_SB(1, 0), cB + kstep, voffB); PG8_STAGE(PG8_SA(1, 0), cA + kstep, voffA); PG8_STAGE(PG8_SB(1, 1), cB + hstepB + kstep, voffB);
    PG8_WAIT_V(6); PG8_BAR;
    for (;;) {
        const bool has_next = S.next(ui + 1, nxt);
        const char* nA = has_next ? (const char*)g.A + (size_t)nxt.pm * tstepA : cA; const char* nB = has_next ? (const char*)g.Bt + (size_t)nxt.pn * tstepB : cB;
        for (int t = 0; t < nt; t += 2) {
            const bool last = (t == nt - 2);
            const char* a1 = cA + (size_t)(t + 1) * kstep;
            const char* a2 = last ? nA : cA + (size_t)(t + 2) * kstep; const char* b2 = last ? nB : cB + (size_t)(t + 2) * kstep;
            const char* a3 = a2 + kstep; const char* b3 = b2 + kstep;
            PG8_LDB(B0, 0, 0); PG8_LDB(B1, 0, 1); PG8_SCHED; PG8_LDA(At, 0, 0); PG8_STAGE(PG8_SA(1, 1), a1 + hstepA, voffA);
            PG8_WAIT_V(8); PG8_WAIT_L(0); PG8_BAR; PG8_MMA(0, 0, At, B0); PG8_MMA(0, 1, At, B1); PG8_BAR; PG8_SCHED;
            PG8_LDA(At, 0, 1); PG8_STAGE(PG8_SB(0, 0), b2, voffB); PG8_STAGE(PG8_SB(0, 1), b2 + hstepB, voffB); PG8_STAGE(PG8_SA(0, 0), a2, voffA);
            PG8_WAIT_V(8); PG8_WAIT_L(0); PG8_BAR; PG8_MMA(1, 0, At, B0); PG8_MMA(1, 1, At, B1); PG8_BAR; PG8_SCHED;
            PG8_LDB(B0, 1, 0); PG8_LDB(B1, 1, 1); PG8_SCHED; PG8_LDA(At, 1, 0); PG8_STAGE(PG8_SA(0, 1), a2 + hstepA, voffA);
            PG8_WAIT_V(8); PG8_WAIT_L(0); PG8_BAR; PG8_MMA(0, 0, At, B0); PG8_MMA(0, 1, At, B1); PG8_BAR; PG8_SCHED;
            PG8_LDA(At, 1, 1); PG8_STAGE(PG8_SB(1, 0), b3, voffB); PG8_STAGE(PG8_SB(1, 1), b3 + hstepB, voffB); PG8_STAGE(PG8_SA(1, 0), a3, voffA);
            PG8_WAIT_V(8); PG8_WAIT_L(0); PG8_BAR; PG8_MMA(1, 0, At, B0); PG8_MMA(1, 1, At, B1); PG8_BAR; PG8_SCHED;
        }
        if constexpr (ALIGN_EPI) { if (wr == 0) PG8_BAR; }
        E(acc, cur, wr, wc, fr, fq);
        if (!has_next) break;
#pragma unroll
        for (int a = 0; a < 2; ++a)
#pragma unroll
            for (int b = 0; b < 2; ++b)
#pragma unroll
                for (int m = 0; m < 4; ++m)
#pragma unroll
                    for (int n = 0; n < 2; ++n) acc[a][b][m][n] = (f32x4){0.f, 0.f, 0.f, 0.f};
        cur = nxt; cA = nA; cB = nB; ++ui;
        if constexpr (ALIGN_EPI) { if (wr == 1) PG8_BAR; }
    }
    PG8_WAIT_V(0);
    if constexpr (!ALIGN_EPI) { if (wr == 0) PG8_BAR; }
    PG8_BAR;
#undef PG8_SA
#undef PG8_SB
#undef PG8_STAGE
#undef PG8_LDA
#undef PG8_LDB
#undef PG8_MMA
#undef PG8_WAIT_V
#undef PG8_WAIT_L
#undef PG8_BAR
#undef PG8_SCHED
}
}
typedef GAS unsigned gu32;
#define RLX_AGENT __ATOMIC_RELAXED, __HIP_MEMORY_SCOPE_AGENT
#define LDS_WAIT() asm volatile("s_waitcnt lgkmcnt(0)" ::: "memory")
#define VM_WAIT() asm volatile("s_waitcnt vmcnt(0)" ::: "memory")
#define XB_TMO      128
#define XB_XCNT(j)  (256  + 64 * (j))
#define XB_XSUB(j)  (1280 + 64 * (j))
#define XB_XGEN(j)  (2304 + 64 * (j))
#define XB_TOP      3328
#define XB_TOPGEN   3392
#define XCD_BAR_WORDS 3456
#define XB_SPIN_CAP (1u << 20)
constexpr int CW_BAR = 1024;
constexpr int CW_QUEUE = 8192;
static_assert((CW_BAR + XCD_BAR_WORDS) * 4 <= (int)CTL_ZERO_BYTES && (CW_QUEUE + 64 * 8) * 4 <= (int)CTL_ZERO_BYTES, "ctl words inside the memset region");

__device__ __forceinline__ unsigned xb_ld(unsigned* p)              { return __hip_atomic_load(p, __ATOMIC_RELAXED, __HIP_MEMORY_SCOPE_AGENT); }
__device__ __forceinline__ unsigned xb_add(unsigned* p, unsigned v) { return __hip_atomic_fetch_add(p, v, __ATOMIC_RELAXED, __HIP_MEMORY_SCOPE_AGENT); }
__device__ __forceinline__ unsigned xb_xcc_id() { return (unsigned)__builtin_amdgcn_s_getreg((3 << 11) | 20) & 0xFu; }
#define XB_SPIN(cond, bar) do { unsigned _sp = 0; while (cond) { __builtin_amdgcn_s_sleep(1); \
    if ((++_sp & 255u) == 0u) { if (xb_ld(&(bar)[XB_TMO])) break; if (_sp > XB_SPIN_CAP) { atomicAdd(&(bar)[XB_TMO], 1u); break; } } } } while (0)

struct XcdBarrier { unsigned* bar; unsigned x; volatile LAS unsigned* st; };
__device__ __forceinline__ XcdBarrier xcd_barrier_post(unsigned* bar, volatile LAS unsigned* st) {
    XcdBarrier b; b.bar = bar; b.x = xb_xcc_id(); b.st = st;
    if (threadIdx.x == 0) (void)xb_add(&bar[XB_XCNT(b.x)], 1u);
    return b;
}
__device__ __forceinline__ void xcd_barrier_complete(unsigned* bar, unsigned x, unsigned& nloc, unsigned& nx) {
    const unsigned G = gridDim.x * gridDim.y * gridDim.z;
    unsigned sum, cnt, mine, sp = 0u;
    for (;;) {
        sum = 0u; cnt = 0u; mine = 0u;
#pragma unroll
        for (unsigned j = 0; j < 16; ++j) { const unsigned c = xb_ld(&bar[XB_XCNT(j)]); sum += c; cnt += (c > 0u) ? 1u : 0u; mine = (j == x) ? c : mine; }
        if (sum == G) break;
        __builtin_amdgcn_s_sleep(1);
        if ((++sp & 255u) == 0u) { if (xb_ld(&bar[XB_TMO])) break; if (sp > XB_SPIN_CAP) { atomicAdd(&bar[XB_TMO], 1u); break; } }
    }
    nloc = mine > 0u ? mine : 1u; nx = cnt > 0u ? cnt : 1u;
}
__device__ __forceinline__ void xcd_barrier(const XcdBarrier& b) {
    asm volatile("s_waitcnt vmcnt(0)" ::: "memory");
    __syncthreads();
    if (threadIdx.x == 0) {
        unsigned* bar = b.bar;
        __builtin_amdgcn_s_waitcnt(0);
        unsigned nloc = b.st[0], nx = b.st[1];
        if (nloc == 0u) { xcd_barrier_complete(bar, b.x, nloc, nx); b.st[0] = nloc; b.st[1] = nx; }
        const unsigned old = xb_add(&bar[XB_XSUB(b.x)], 1u);
        const unsigned gen = old / nloc;
        if (old + 1u == (gen + 1u) * nloc) {
            __builtin_amdgcn_fence(__ATOMIC_RELEASE, "agent");
            asm volatile("s_waitcnt vmcnt(0)" ::: "memory");
            const unsigned og = xb_add(&bar[XB_TOP], 1u);
            const unsigned tg = og / nx;
            if (og + 1u == (tg + 1u) * nx) xb_add(&bar[XB_TOPGEN], 1u);
            else XB_SPIN(xb_ld(&bar[XB_TOPGEN]) == tg, bar);
            __builtin_amdgcn_fence(__ATOMIC_ACQUIRE, "agent");
            xb_add(&bar[XB_XGEN(b.x)], 1u);
            asm volatile("s_waitcnt vmcnt(0)" ::: "memory");
        } else {
            XB_SPIN(xb_ld(&bar[XB_XGEN(b.x)]) == gen, bar);
            __builtin_amdgcn_fence(__ATOMIC_ACQUIRE, "agent");
            asm volatile("s_waitcnt vmcnt(0)" ::: "memory");
        }
    }
    __syncthreads();
}

struct Args { const float* in[25]; float* out; unsigned char* ws; int ph_lo, ph_hi; };
static_assert(sizeof(Args) == 25 * 8 + 8 + 8 + 8, "no padding");

__device__ __forceinline__ void tr_item(const float* W, const float* gain, bf16_t* Wt, int K, int N, int mode, int roff, bool qscale, LAS float* scr, int item, int lane) {
    const int nblk = (N + 31) >> 5, kb = item / nblk, nb = item - kb * nblk, k0 = 64 * kb, n0 = 32 * nb;
#pragma unroll 8
    for (int i = 0; i < 32; ++i) {
        const int kk = 2 * i + (lane >> 5), n = n0 + (lane & 31);
        float v = 0.f;
        if (n < N) { v = W[(size_t)(k0 + kk) * N + n]; if (gain) v *= gain[k0 + kk]; }
        scr[kk * 33 + (lane & 31)] = v;
    }
    LDS_WAIT(); asm volatile("" ::: "memory");
    const int c = lane & 7;
#pragma unroll
    for (int j = 0; j < 4; ++j) {
        const int nl = (lane >> 3) + 8 * j, n = n0 + nl;
        if (n < N) {
            const LAS float* s = scr + (8 * c) * 33 + nl;
            const float sc = (qscale && ((n >= ZC_QN && n < ZC_QN + 512) || (n >= ZC_QM && n < ZC_QM + 512))) ? C2 : 1.f;
            u32x4 o;
            o.x = pk2(s[0 * 33] * sc, s[1 * 33] * sc); o.y = pk2(s[2 * 33] * sc, s[3 * 33] * sc);
            o.z = pk2(s[4 * 33] * sc, s[5 * 33] * sc); o.w = pk2(s[6 * 33] * sc, s[7 * 33] * sc);
            const int drow = mode ? ((n >> 7) * 256 + (n & 127) + roff) : n;
            *(u32x4*)(Wt + (size_t)drow * K + k0 + 8 * c) = o;
        }
    }
    LDS_WAIT(); asm volatile("" ::: "memory");
}
constexpr int trcnt(int K, int N) { return (K / 64) * ((N + 31) / 32); }
constexpr int I_W13 = trcnt(D_, F_), I_W2 = trcnt(F_, D_), I_WIN = trcnt(D_, NIN), I_WUP = trcnt(512, D_), I_WDD = trcnt(D_, D_), I_WPLE = trcnt(PLE_, D_), I_WC1 = trcnt(2048, 128);
constexpr int TR_NITEMS = 4 * I_W13 + 2 * I_W2 + I_WIN + 2 * I_WUP + 2 * I_WDD + I_WPLE + 2 * I_WC1;

__device__ __forceinline__ void p0_prologue(const Args& a, LAS unsigned char* lds, int vcu, int G, int wave, int lane, int tid) {
    unsigned char* ws = a.ws;
    LAS float* scr = (LAS float*)(lds + wave * 16384);
    const int gw = vcu * NWAVES + wave, NGW = G * NWAVES;
    for (int it = gw; it < TR_NITEMS; it += NGW) {
        int r = it;
        if (r < I_W13) { tr_item(a.in[3], a.in[2], (bf16_t*)(ws + WS_W13A), D_, F_, 1, 0, false, scr, r, lane); continue; } r -= I_W13;
        if (r < I_W13) { tr_item(a.in[4], a.in[2], (bf16_t*)(ws + WS_W13A), D_, F_, 1, 128, false, scr, r, lane); continue; } r -= I_W13;
        if (r < I_W2) { tr_item(a.in[5], nullptr, (bf16_t*)(ws + WS_W2A), F_, D_, 0, 0, false, scr, r, lane); continue; } r -= I_W2;
        if (r < I_W13) { tr_item(a.in[18], a.in[17], (bf16_t*)(ws + WS_W13B), D_, F_, 1, 0, false, scr, r, lane); continue; } r -= I_W13;
        if (r < I_W13) { tr_item(a.in[19], a.in[17], (bf16_t*)(ws + WS_W13B), D_, F_, 1, 128, false, scr, r, lane); continue; } r -= I_W13;
        if (r < I_W2) { tr_item(a.in[20], nullptr, (bf16_t*)(ws + WS_W2B), F_, D_, 0, 0, false, scr, r, lane); continue; } r -= I_W2;
        if (r < I_WIN) { tr_item(a.in[7], a.in[6], (bf16_t*)(ws + WS_WIN), D_, NIN, 0, 0, true, scr, r, lane); continue; } r -= I_WIN;
        if (r < I_WUP) { tr_item(a.in[14], nullptr, (bf16_t*)(ws + WS_WUPN), 512, D_, 0, 0, false, scr, r, lane); continue; } r -= I_WUP;
        if (r < I_WUP) { tr_item(a.in[15], nullptr, (bf16_t*)(ws + WS_WUPM), 512, D_, 0, 0, false, scr, r, lane); continue; } r -= I_WUP;
        if (r < I_WDD) { tr_item(a.in[16], nullptr, (bf16_t*)(ws + WS_WOUT), D_, D_, 0, 0, false, scr, r, lane); continue; } r -= I_WDD;
        if (r < I_WDD) { tr_item(a.in[22], a.in[21], (bf16_t*)(ws + WS_WPG), D_, D_, 0, 0, false, scr, r, lane); continue; } r -= I_WDD;
        if (r < I_WPLE) { tr_item(a.in[23], nullptr, (bf16_t*)(ws + WS_WPLE), PLE_, D_, 0, 0, false, scr, r, lane); continue; } r -= I_WPLE;
        if (r < I_WC1) { tr_item(a.in[9], nullptr, (bf16_t*)(ws + WS_WC1K), 2048, 128, 0, 0, false, scr, r, lane); continue; } r -= I_WC1;
        tr_item(a.in[12], nullptr, (bf16_t*)(ws + WS_WC1V), 2048, 128, 0, 0, false, scr, r, lane);
    }
    { const float* x = a.in[0]; bf16_t* xb = (bf16_t*)(ws + WS_AB); float* ss = (float*)(ws + WS_SS);
      for (int row = gw; row < M_; row += NGW) {
          const f32x4* xr = (const f32x4*)(x + (size_t)row * D_) + lane; u32x2* o = (u32x2*)(xb + (size_t)row * D_) + lane; float s = 0.f;
#pragma unroll
          for (int j = 0; j < 4; ++j) { const f32x4 v = xr[64 * j]; s += (v[0] * v[0] + v[1] * v[1]) + (v[2] * v[2] + v[3] * v[3]); u32x2 w; w.x = cvtpk(v[0], v[1]); w.y = cvtpk(v[2], v[3]); o[64 * j] = w; }
          s = wsum(s);
          if (lane < 16) ss[(size_t)row * 16 + lane] = lane == 0 ? s : 0.f;
      } }
    { const f32x4* p = (const f32x4*)a.in[1]; u32x4* pb = (u32x4*)(ws + WS_PB); const int gt = vcu * NTHR + tid, NGT = G * NTHR;
      for (int i = gt; i < M_ * PLE_ / 8; i += NGT) { const f32x4 u = p[2 * i], v = p[2 * i + 1]; u32x4 o; o.x = cvtpk(u[0], u[1]); o.y = cvtpk(u[2], u[3]); o.z = cvtpk(v[0], v[1]); o.w = cvtpk(v[2], v[3]); pb[i] = o; }
      u32x4* wz = (u32x4*)(ws + WS_WIN + (size_t)NIN * D_ * 2);
      for (int i = gt; i < (NINP - NIN) * D_ * 2 / 16; i += NGT) wz[i] = (u32x4){0u, 0u, 0u, 0u}; }
    if (gw < 256) { const int kv = gw >> 7, j = gw & 127; const float* pos = a.in[kv ? 11 : 8]; const float* w1 = a.in[kv ? 12 : 9]; float s = 0.f;
        for (int i = lane; i < 2048; i += 64) s += pos[i] * w1[(size_t)i * 128 + j];
        s = wsum(s); if (lane == 0) ((float*)(ws + WS_CBIAS))[gw] = s; }
}

__device__ __forceinline__ float gelu_tanh(float x) { const float u = 0.7978845608028654f * (x + 0.044715f * x * x * x); return 0.5f * x * (1.f + tanhf(u)); }
__device__ __forceinline__ float dot64(const LAS float* q, const bf16_t* row) {
    const u32x4* r = (const u32x4*)row; float s = 0.f;
#pragma unroll
    for (int i = 0; i < 8; ++i) { const u32x4 v = r[i]; const LAS float* qq = q + 8 * i;
        s += qq[0] * bflo(v.x) + qq[1] * bfhi(v.x) + qq[2] * bflo(v.y) + qq[3] * bfhi(v.y) + qq[4] * bflo(v.z) + qq[5] * bfhi(v.z) + qq[6] * bflo(v.w) + qq[7] * bfhi(v.w); }
    return s;
}
__device__ __forceinline__ void chunk_step(const LAS float* q, const bf16_t* kbase, const bf16_t* vbase, int kpos0, int t, int kmin, float slope2, int lane, float& m, float& l, float& o) {
    const int kpos = kpos0 + lane; const bool ok = kpos <= t && kpos >= kmin;
    float s = -1e30f;
    if (ok) s = dot64(q, kbase + (size_t)lane * ZP) - slope2 * (float)(t - kpos);
    const float mn = fmaxf(m, wmax(s)); const float alpha = exp2f(m - mn); const float p = ok ? exp2f(s - mn) : 0.f;
    l = l * alpha + wsum(p); o *= alpha; m = mn;
    for (int key = 0; key < 64; ++key) { const float pk = __shfl(p, key); if (pk != 0.f) o += pk * bf2f(vbase[(size_t)key * ZP + lane]); }
}
__device__ __forceinline__ void cmp_phase_simple(const Args& a, LAS unsigned char* lds, int vcu, int G, int tid) {
    unsigned char* ws = a.ws; const bf16_t* Z = (const bf16_t*)(ws + WS_R);
    const int sub = tid >> 7, st = tid & 127;
    LAS float* xin = (LAS float*)lds + sub * 2048; LAS float* hid = (LAS float*)(lds + 32768) + sub * 128;
    for (int it0 = vcu * 4; it0 < 4096; it0 += G * 4) {
        const int it = it0 + sub, kv = it >> 11, bg = (it >> 7) & 15, c = it & 127, b = bg >> 1, g = bg & 1;
        bf16_t* outc = (bf16_t*)(ws + (kv ? WS_VC : WS_KC)) + ((size_t)bg * 128 + c) * 64;
        const int coloff = (kv ? ZC_VCMP : ZC_KCMP) + g * 64;
        if (c < 127) for (int i = st; i < 2048; i += 128) { const int l = i >> 6, d = i & 63; xin[i] = bf2f(Z[((size_t)b * S_ + 16 * c + l) * ZP + coloff + d]); }
        __syncthreads();
        if (c < 127) {
            const bf16_t* w1 = (const bf16_t*)(ws + (kv ? WS_WC1V : WS_WC1K)) + (size_t)st * 2048;
            float acc = ((const float*)(ws + WS_CBIAS))[kv * 128 + st];
            for (int i = 0; i < 2048; i += 8) { const u32x4 w = *(const u32x4*)(w1 + i);
                acc += xin[i] * bflo(w.x) + xin[i + 1] * bfhi(w.x) + xin[i + 2] * bflo(w.y) + xin[i + 3] * bfhi(w.y) + xin[i + 4] * bflo(w.z) + xin[i + 5] * bfhi(w.z) + xin[i + 6] * bflo(w.w) + xin[i + 7] * bfhi(w.w); }
            hid[st] = gelu_tanh(acc);
        }
        __syncthreads();
        if (st < 64) { float s = 0.f; if (c < 127) { const float* w2 = a.in[kv ? 13 : 10]; for (int j = 0; j < 128; ++j) s += hid[j] * w2[j * 64 + st]; } outc[st] = (bf16_t)f2bf(s); }
        __syncthreads();
    }
}
__device__ __forceinline__ void kmean_phase_simple(const Args& a, int vcu, int G, int wave, int lane) {
    const bf16_t* Z = (const bf16_t*)(a.ws + WS_R); float* kmean = (float*)(a.ws + WS_KMEAN);
    for (int it = vcu * NWAVES + wave; it < 512; it += G * NWAVES) {
        const int n = it & 7, h = (it >> 3) & 7, b = it >> 6; float s = 0.f;
        for (int i = 0; i < 256; ++i) s += bf2f(Z[((size_t)b * S_ + 256 * n + i) * ZP + ZC_KM + h * 64 + lane]);
        kmean[(size_t)it * 64 + lane] = s * (1.f / 256.f);
    }
}
__device__ __forceinline__ void nsa_item_simple(bf16_t* Z, const bf16_t* kc, const bf16_t* vc, int b, int t, LAS float* L, int tid) {
    const int lane = tid & 63, h = tid >> 6, g = h >> 2, bg = b * 2 + g;
    LAS float* q_s = L; LAS float* p_s = L + 512; LAS float* imp_s = L + 1536; LAS unsigned* mask_s = (LAS unsigned*)(L + 1600);
    bf16_t* zrow = Z + ((size_t)b * S_ + t) * ZP;
    q_s[h * 64 + lane] = bf2f(zrow[ZC_QN + h * 64 + lane]);
    const float slope2 = exp2f(-(float)(2 * h + 1) * 0.5f) * LOG2E;
    __syncthreads();
    const LAS float* q = q_s + h * 64;
    const int ncv = t >= 31 ? ((t - 31) >> 4) + 1 : 0;
    const bool ok0 = lane < ncv, ok1 = lane + 64 < ncv;
    float s0 = -1e30f, s1 = -1e30f;
    if (ok0) s0 = dot64(q, kc + ((size_t)bg * 128 + lane) * 64) - slope2 * (float)(t - (16 * lane + 31));
    if (ok1) s1 = dot64(q, kc + ((size_t)bg * 128 + lane + 64) * 64) - slope2 * (float)(t - (16 * (lane + 64) + 31));
    const float mc = wmax(fmaxf(s0, s1));
    const float e0 = ok0 ? exp2f(s0 - mc) : 0.f, e1 = ok1 ? exp2f(s1 - mc) : 0.f;
    const float lc = wsum(e0 + e1), inv = 1.f / fmaxf(lc, 1e-30f);
    p_s[h * 128 + lane] = e0 * inv; p_s[h * 128 + lane + 64] = e1 * inv;
    __syncthreads();
    if (tid < 64) {
        const int gg = tid >> 5, j = tid & 31, lo = max(0, 4 * j - 1), hi = min(126, 4 * j + 3); float s = 0.f;
        for (int hh = 0; hh < 4; ++hh) for (int c = lo; c <= hi; ++c) s += p_s[(gg * 4 + hh) * 128 + c];
        imp_s[gg * 32 + j] = s;
    }
    __syncthreads();
    const int cur = t >> 6;
    if (tid < 64) {
        const int gg = lane >> 5, j = lane & 31;
        const bool causal = j <= cur, forced = (j == 0) || (j == cur) || (j == cur - 1);
        const float val = !causal ? -1e30f : (forced ? 1e9f : imp_s[gg * 32 + j]);
        int rank = 0;
        for (int jj = 0; jj < 32; ++jj) {
            const bool cj = jj <= cur, fj = (jj == 0) || (jj == cur) || (jj == cur - 1);
            const float vv = !cj ? -1e30f : (fj ? 1e9f : imp_s[gg * 32 + jj]);
            rank += (vv > val || (vv == val && jj < j)) ? 1 : 0;
        }
        const unsigned long long bal = __ballot(rank < 16 && causal);
        if (lane == 0) { mask_s[0] = (unsigned)bal; mask_s[1] = (unsigned)(bal >> 32); }
    }
    __syncthreads();
    const unsigned mask = mask_s[g];
    float oc = 0.f;
    for (int c = 0; c < ncv; ++c) oc += p_s[h * 128 + c] * bf2f(vc[((size_t)bg * 128 + c) * 64 + lane]);
    const bf16_t* zb = Z + (size_t)b * S_ * ZP;
    float ms = -1e30f, ls = 0.f, os = 0.f;
    for (int j = 0; j <= cur; ++j) {
        if (!((mask >> j) & 1u)) continue;
        chunk_step(q, zb + (size_t)(64 * j) * ZP + ZC_KSLC + g * 64, zb + (size_t)(64 * j) * ZP + ZC_VSLC + g * 64, 64 * j, t, 0, slope2, lane, ms, ls, os);
    }
    float mw = -1e30f, lw = 0.f, ow = 0.f;
    const int kmin = max(0, t - 511);
    for (int k0 = kmin & ~63; k0 <= t; k0 += 64)
        chunk_step(q, zb + (size_t)k0 * ZP + ZC_KWIN + g * 64, zb + (size_t)k0 * ZP + ZC_VWIN + g * 64, k0, t, kmin, slope2, lane, mw, lw, ow);
    const float g0 = bf2f(zrow[ZC_GATE + h * 3 + 0]), g1 = bf2f(zrow[ZC_GATE + h * 3 + 1]), g2 = bf2f(zrow[ZC_GATE + h * 3 + 2]);
    const float o = g0 * oc + g1 * (os / ls) + g2 * (ow / lw);
    zrow[ZC_QN + h * 64 + lane] = (bf16_t)f2bf(o);
    __syncthreads();
}
__device__ __forceinline__ void moba_item_simple(bf16_t* Z, const float* kmean, int b, int t, LAS float* L, int tid) {
    const int lane = tid & 63, h = tid >> 6;
    bf16_t* zrow = Z + ((size_t)b * S_ + t) * ZP;
    const float qv = bf2f(zrow[ZC_QM + h * 64 + lane]);
    L[h * 64 + lane] = qv;
    const float slope2 = exp2f(-(float)(h + 1)) * LOG2E;
    __syncthreads();
    const LAS float* q = L + h * 64;
    const int cur = t >> 8;
    float gs[8];
#pragma unroll
    for (int j = 0; j < 8; ++j) { gs[j] = -1e30f; if (j < cur) gs[j] = wsum(qv * kmean[(((size_t)b * 8 + h) * 8 + j) * 64 + lane]); }
    unsigned sel = 0;
#pragma unroll
    for (int j = 0; j < 8; ++j) {
        int rank = 0;
#pragma unroll
        for (int jj = 0; jj < 8; ++jj) rank += (gs[jj] > gs[j] || (gs[jj] == gs[j] && jj < j)) ? 1 : 0;
        if (j < cur && rank < 3) sel |= 1u << j;
    }
    const bf16_t* zb = Z + (size_t)b * S_ * ZP;
    float m = -1e30f, l = 0.f, o = 0.f;
    for (int j = 0; j < cur; ++j) {
        if (!((sel >> j) & 1u)) continue;
        for (int k0 = 256 * j; k0 < 256 * j + 256; k0 += 64)
            chunk_step(q, zb + (size_t)k0 * ZP + ZC_KM + h * 64, zb + (size_t)k0 * ZP + ZC_VM + h * 64, k0, t, 0, slope2, lane, m, l, o);
    }
    for (int k0 = 256 * cur; k0 <= t; k0 += 64)
        chunk_step(q, zb + (size_t)k0 * ZP + ZC_KM + h * 64, zb + (size_t)k0 * ZP + ZC_VM + h * 64, k0, t, 0, slope2, lane, m, l, o);
    zrow[ZC_QM + h * 64 + lane] = (bf16_t)f2bf(o / l);
    __syncthreads();
}
constexpr int RING_OFF = 0, RING_BYTES = 131072;
constexpr int MISC_OFF = RING_BYTES;
constexpr int LDS_BYTES = 147456;
constexpr int N_PHASES = 12;

__global__ void __launch_bounds__(NTHR, 2) mega(Args args) {
    extern __shared__ __attribute__((aligned(16))) unsigned char lds_raw[];
    LAS unsigned char* lds = (LAS unsigned char*)lds_raw;
    const int tid = threadIdx.x, lane = tid & 63, wave = __builtin_amdgcn_readfirstlane(tid >> 6);
    const int G = gridDim.x, bx = blockIdx.x;
    const int vcu = (G % 8 == 0) ? (bx % 8) * (G / 8) + bx / 8 : bx;
    volatile LAS unsigned* MISC = (volatile LAS unsigned*)(lds + MISC_OFF);
    if (tid < 32) MISC[tid] = 0u;
    __syncthreads();
    unsigned char* ws = args.ws;
    const int lo = args.ph_lo, hi = args.ph_hi;
    XcdBarrier bar; bar.bar = (unsigned*)(ws + WS_CTL) + CW_BAR; bar.x = 0; bar.st = MISC + 8;
    if (hi - lo > 1) bar = xcd_barrier_post((unsigned*)(ws + WS_CTL) + CW_BAR, MISC + 8);
#define IN(k) (lo <= (k) && (k) < hi)
#define SEAM(k) do { if (IN(k) && IN((k) + 1)) xcd_barrier(bar); } while (0)
    float* out = args.out;
    bf16_t* AB = (bf16_t*)(ws + WS_AB); bf16_t* AB2 = (bf16_t*)(ws + WS_AB2); bf16_t* HID = (bf16_t*)(ws + WS_R); bf16_t* Z = (bf16_t*)(ws + WS_R); float* PE = (float*)(ws + WS_R);
    float* SS1 = (float*)(ws + WS_SS); float* SS2 = (float*)(ws + WS_SS + SZ_SS); float* SS3 = (float*)(ws + WS_SS + 2 * SZ_SS); float* SS4 = (float*)(ws + WS_SS + 3 * SZ_SS); float* SS5 = (float*)(ws + WS_SS + 4 * SZ_SS);

    if (IN(0)) { p0_prologue(args, lds, vcu, G, wave, lane, tid); SEAM(0); }
    if (IN(1)) { pg8::Gemm g{AB, (const bf16_t*)(ws + WS_W13A), D_, D_, M_, 2 * F_, D_}; pg8::StaticOrder S; S.init(M_, 2 * F_, G, bx);
        pg8::EpiSwiglu E{SS1, HID}; pg8::gemm_phase<pg8::EpiSwiglu, pg8::StaticOrder, true>(lds + RING_OFF, g, S, E); SEAM(1); }
    if (IN(2)) { pg8::Gemm g{HID, (const bf16_t*)(ws + WS_W2A), F_, F_, M_, D_, F_}; pg8::StaticOrder S; S.init(M_, D_, G, bx);
        pg8::EpiRes E{args.in[0], out, AB, SS2, 0.5f}; pg8::gemm_phase<pg8::EpiRes, pg8::StaticOrder, false>(lds + RING_OFF, g, S, E); SEAM(2); }
    if (IN(3)) { pg8::Gemm g{AB, (const bf16_t*)(ws + WS_WIN), D_, D_, M_, NINP, D_}; pg8::StaticOrder S; S.init(M_, NINP, G, bx);
        pg8::EpiInproj E{SS2, Z}; pg8::gemm_phase<pg8::EpiInproj, pg8::StaticOrder, true>(lds + RING_OFF, g, S, E); SEAM(3); }
    if (IN(4)) { cmp_phase_simple(args, lds, vcu, G, tid); kmean_phase_simple(args, vcu, G, wave, lane); SEAM(4); }
    if (IN(5)) {
        const bf16_t* kc = (const bf16_t*)(ws + WS_KC); const bf16_t* vc = (const bf16_t*)(ws + WS_VC); const float* kmean = (const float*)(ws + WS_KMEAN);
        for (int it = vcu; it < M_; it += G) { nsa_item_simple(Z, kc, vc, it >> 11, it & 2047, (LAS float*)lds, tid); moba_item_simple(Z, kmean, it >> 11, it & 2047, (LAS float*)lds, tid); }
        SEAM(5); }
    if (IN(6)) {
        { pg8::Gemm g{Z + ZC_QN, (const bf16_t*)(ws + WS_WUPN), ZP, 512, M_, D_, 512}; pg8::StaticOrder S; S.init(M_, D_, G, bx);
          pg8::EpiUpmix<0> E{Z, AB}; pg8::gemm_phase<pg8::EpiUpmix<0>, pg8::StaticOrder, false>(lds + RING_OFF, g, S, E); }
        { pg8::Gemm g{Z + ZC_QM, (const bf16_t*)(ws + WS_WUPM), ZP, 512, M_, D_, 512}; pg8::StaticOrder S; S.init(M_, D_, G, bx);
          pg8::EpiUpmix<1> E{Z, AB}; pg8::gemm_phase<pg8::EpiUpmix<1>, pg8::StaticOrder, false>(lds + RING_OFF, g, S, E); }
        SEAM(6); }
    if (IN(7)) { pg8::Gemm g{AB, (const bf16_t*)(ws + WS_WOUT), D_, D_, M_, D_, D_}; pg8::StaticOrder S; S.init(M_, D_, G, bx);
        pg8::EpiRes E{out, out, AB2, SS3, 1.0f}; pg8::gemm_phase<pg8::EpiRes, pg8::StaticOrder, false>(lds + RING_OFF, g, S, E); SEAM(7); }
    if (IN(8)) { pg8::Gemm g{AB2, (const bf16_t*)(ws + WS_W13B), D_, D_, M_, 2 * F_, D_}; pg8::StaticOrder S; S.init(M_, 2 * F_, G, bx);
        pg8::EpiSwiglu E{SS3, HID}; pg8::gemm_phase<pg8::EpiSwiglu, pg8::StaticOrder, true>(lds + RING_OFF, g, S, E); SEAM(8); }
    if (IN(9)) { pg8::Gemm g{HID, (const bf16_t*)(ws + WS_W2B), F_, F_, M_, D_, F_}; pg8::StaticOrder S; S.init(M_, D_, G, bx);
        pg8::EpiRes E{out, out, AB, SS4, 0.5f}; pg8::gemm_phase<pg8::EpiRes, pg8::StaticOrder, false>(lds + RING_OFF, g, S, E); SEAM(9); }
    if (IN(10)) {
        { pg8::Gemm g{(const bf16_t*)(ws + WS_PB), (const bf16_t*)(ws + WS_WPLE), PLE_, PLE_, M_, D_, PLE_}; pg8::StaticOrder S; S.init(M_, D_, G, bx);
          pg8::EpiPe E{PE}; pg8::gemm_phase<pg8::EpiPe, pg8::StaticOrder, false>(lds + RING_OFF, g, S, E); }
        { pg8::Gemm g{AB, (const bf16_t*)(ws + WS_WPG), D_, D_, M_, D_, D_}; pg8::StaticOrder S; S.init(M_, D_, G, bx);
          pg8::EpiPle E{SS4, PE, out, SS5}; pg8::gemm_phase<pg8::EpiPle, pg8::StaticOrder, false>(lds + RING_OFF, g, S, E); }
        SEAM(10); }
    if (IN(11)) {
        const f32x4* gn = (const f32x4*)args.in[24] + lane;
        for (int row = vcu * NWAVES + wave; row < M_; row += G * NWAVES) {
            const float rs = pg8::rs_from_ss(SS5, row, lane >> 4);
            f32x4* hr = (f32x4*)(out + (size_t)row * D_) + lane;
#pragma unroll
            for (int j = 0; j < 4; ++j) { f32x4 v = hr[64 * j]; const f32x4 gg = gn[64 * j]; v = v * gg * rs; hr[64 * j] = v; }
        }
    }
#undef IN
#undef SEAM
}
}

extern "C" void kernel_launch(void* const* d_in, const int* in_sizes, int n_in, void* d_out, int out_size, void* d_ws, size_t ws_size, hipStream_t stream) {
    static int grid = 0;
    if (grid == 0) {
        if (n_in != 25 || ws_size < WS_END || out_size != M_ * D_) { fprintf(stderr, "kernel_launch: unexpected n_in %d / out_size %d / ws_size %zu (need %zu)\n", n_in, out_size, ws_size, (size_t)WS_END); grid = -1; return; }
        int dev = 0, cus = 0, per_cu = 0;
        if (hipGetDevice(&dev) != hipSuccess || hipDeviceGetAttribute(&cus, hipDeviceAttributeMultiprocessorCount, dev) != hipSuccess) { grid = -1; return; }
        if (hipFuncSetAttribute((const void*)mega, hipFuncAttributeMaxDynamicSharedMemorySize, LDS_BYTES) != hipSuccess) { fprintf(stderr, "kernel_launch: hipFuncSetAttribute failed\n"); grid = -1; return; }
        if (hipOccupancyMaxActiveBlocksPerMultiprocessor(&per_cu, (const void*)mega, NTHR, LDS_BYTES) != hipSuccess || per_cu < 1) fprintf(stderr, "kernel_launch: occupancy query reports %d\n", per_cu);
        (void)hipGetLastError();
        grid = cus;
    }
    if (grid < 0) return;
    (void)hipMemsetAsync((char*)d_ws + WS_CTL, 0, CTL_ZERO_BYTES, stream);
    Args a{};
    for (int i = 0; i < 25; ++i) a.in[i] = (const float*)d_in[i];
    a.out = (float*)d_out; a.ws = (unsigned char*)d_ws;
#if MK_N_LAUNCHES == 1
    a.ph_lo = 0; a.ph_hi = N_PHASES;
    hipLaunchKernelGGL(mega, dim3(grid), dim3(NTHR), LDS_BYTES, stream, a);
#else
    for (int k = 0; k < N_PHASES; ++k) { a.ph_lo = k; a.ph_hi = k + 1; hipLaunchKernelGGL(mega, dim3(grid), dim3(NTHR), LDS_BYTES, stream, a); }
#endif
}
```

```cpp
#include <hip/hip_runtime.h>
#include <cstdint>
#include <cstdio>

#ifndef MK_N_LAUNCHES
#define MK_N_LAUNCHES 1
#endif

namespace {
typedef unsigned short bf16_t;
#define LAS __attribute__((address_space(3)))
#define GAS __attribute__((address_space(1)))
typedef short bf16x8 __attribute__((ext_vector_type(8)));
typedef float f32x4 __attribute__((ext_vector_type(4)));
typedef float f32x16 __attribute__((ext_vector_type(16)));
typedef unsigned u32x4 __attribute__((ext_vector_type(4)));
typedef unsigned u32x2 __attribute__((ext_vector_type(2)));

constexpr int B_ = 8, S_ = 2048, D_ = 1024, M_ = B_ * S_;
constexpr int F_ = 2816, NIN = 4888, NINP = 5120, PLE_ = 256;
constexpr int ZP = NIN;
constexpr int ZC_QN = 0, ZC_KCMP = 512, ZC_VCMP = 640, ZC_KSLC = 768, ZC_VSLC = 896, ZC_KWIN = 1024, ZC_VWIN = 1152,
              ZC_GATE = 1280, ZC_QM = 1304, ZC_KM = 1816, ZC_VM = 2328, ZC_GA = 2840, ZC_GB = 3864;
constexpr float LOG2E = 1.4426950408889634f;
constexpr float C2 = 0.125f * LOG2E;
constexpr int NWAVES = 8, NTHR = 512;

constexpr size_t MiB = 1u << 20;
constexpr size_t WS_CTL = 0, CTL_ZERO_BYTES = 64 * 1024;
constexpr size_t WS_W13A = 1 * MiB;
constexpr size_t SZ_W13 = (size_t)2 * F_ * D_ * 2, SZ_W2 = (size_t)D_ * F_ * 2;
constexpr size_t WS_W2A = WS_W13A + SZ_W13;
constexpr size_t WS_W13B = WS_W2A + SZ_W2;
constexpr size_t WS_W2B = WS_W13B + SZ_W13;
constexpr size_t WS_WIN = WS_W2B + SZ_W2;
constexpr size_t WS_WUPN = WS_WIN + (size_t)NINP * D_ * 2;
constexpr size_t WS_WUPM = WS_WUPN + (size_t)D_ * 512 * 2;
constexpr size_t WS_WOUT = WS_WUPM + (size_t)D_ * 512 * 2;
constexpr size_t WS_WPG = WS_WOUT + (size_t)D_ * D_ * 2;
constexpr size_t WS_WPLE = WS_WPG + (size_t)D_ * D_ * 2;
constexpr size_t WS_WC1K = WS_WPLE + (size_t)D_ * PLE_ * 2;
constexpr size_t WS_WC1V = WS_WC1K + (size_t)128 * 2048 * 2;
constexpr size_t WS_CBIAS = WS_WC1V + (size_t)128 * 2048 * 2;
constexpr size_t WS_KC = WS_CBIAS + 4096;
constexpr size_t WS_VC = WS_KC + (size_t)16 * 128 * 64 * 2;
constexpr size_t WS_KMEAN = WS_VC + (size_t)16 * 128 * 64 * 2;
constexpr size_t WS_SS = WS_KMEAN + (size_t)8 * 8 * 8 * 64 * 4;
constexpr size_t SZ_SS = (size_t)M_ * 16 * 4;
constexpr size_t WS_AB = WS_SS + 5 * SZ_SS;
constexpr size_t WS_PB = WS_AB + (size_t)M_ * D_ * 2;
constexpr size_t WS_R = WS_PB + (size_t)M_ * PLE_ * 2;
constexpr size_t SZ_Z = (size_t)M_ * ZP * 2, SZ_HID = (size_t)M_ * F_ * 2;
constexpr size_t WS_AB2 = WS_R + SZ_HID;
constexpr size_t WS_END = WS_R + SZ_Z;
static_assert(WS_AB2 + (size_t)M_ * D_ * 2 <= WS_END, "AB2 inside R");
static_assert((size_t)M_ * D_ * 4 <= SZ_Z, "pe temp inside R");
static_assert(WS_END <= 256 * MiB, "workspace map must fit 256 MiB");
static_assert((WS_R % 256) == 0 && (WS_AB % 256) == 0 && (WS_KC % 256) == 0 && (WS_SS % 256) == 0, "alignment");

__device__ __forceinline__ float bf2f(bf16_t v) { return __uint_as_float(((unsigned)v) << 16); }
__device__ __forceinline__ float bflo(unsigned u) { return __uint_as_float(u << 16); }
__device__ __forceinline__ float bfhi(unsigned u) { return __uint_as_float(u & 0xffff0000u); }
__device__ __forceinline__ unsigned f2bf(float f) { unsigned u = __float_as_uint(f); return (u + 0x7fffu + ((u >> 16) & 1u)) >> 16; }
__device__ __forceinline__ unsigned pk2(float lo, float hi) { return f2bf(lo) | (f2bf(hi) << 16); }
typedef float f32x2_t __attribute__((ext_vector_type(2)));
typedef __bf16 bf16x2_t __attribute__((ext_vector_type(2)));
__device__ __forceinline__ unsigned cvtpk(float lo, float hi) { f32x2_t v = {lo, hi}; bf16x2_t b = __builtin_convertvector(v, bf16x2_t); return __builtin_bit_cast(unsigned, b); }
__device__ __forceinline__ float wsum(float v) {
#pragma unroll
    for (int o = 32; o > 0; o >>= 1) v += __shfl_xor(v, o);
    return v;
}
__device__ __forceinline__ float wmax(float v) {
#pragma unroll
    for (int o = 32; o > 0; o >>= 1) v = fmaxf(v, __shfl_xor(v, o));
    return v;
}
__device__ __forceinline__ float fsigmoid(float x) { return __builtin_amdgcn_rcpf(1.f + __builtin_amdgcn_exp2f(-LOG2E * x)); }
namespace pg8 {
constexpr int BM = 256, BK = 64, HALF = 128, HTB = HALF * BK * 2  , STAGE_BYTES = 8 * HTB, NXCD = 8, WGM = 8;
__host__ __device__ __forceinline__ int lds_byte(int r, int c) { const int st = (r >> 4) * 2 + (c >> 5), rr = r & 15, cc = c & 31, ob = rr * 64 + cc * 2; return st * 1024 + (ob ^ (((ob >> 9) & 1) << 5)); }
__host__ __device__ __forceinline__ void stage_rc(int b, int& R, int& C) { const int st = b / 1024, sb = b % 1024, swz = sb ^ (((sb >> 9) & 1) << 5); R = (st >> 1) * 16 + swz / 64; C = (st & 1) * 32 + (swz % 64) / 2; }
__host__ __device__ __forceinline__ int perm32(int rho) { const int n = rho >> 4, i = rho & 15; return 8 * (i >> 2) + 4 * n + (i & 3); }

struct Unit { int pm, pn; };
struct Gemm { const bf16_t* A; const bf16_t* Bt; int lda, ldb, M, N, K; };

struct StaticOrder {
    int nM, nN, nwg, G, c;
    __host__ __device__ void init(int M, int N, int G_, int c_) { nM = M / BM; nN = N / BM; nwg = nM * nN; G = G_; c = c_; }
    __host__ __device__ bool next(int i, Unit& u) const {
        const long L = (long)i * G + c; if (L >= nwg) return false;
        int wgid = (int)L; { const int q = nwg / NXCD, r = nwg % NXCD, xcd = wgid % NXCD, off = wgid / NXCD; wgid = (xcd < r ? xcd * (q + 1) : r * (q + 1) + (xcd - r) * q) + off; }
        const int nig = WGM * nN, gid = wgid / nig, fm = gid * WGM, gsz = (nM - fm) < WGM ? (nM - fm) : WGM;
        u.pm = fm + ((wgid % nig) % gsz); u.pn = (wgid % nig) / gsz; return true;
    }
};

__device__ __forceinline__ float rs_from_ss(const float* ss, int row, int fq) {
    const f32x4 v = *(const f32x4*)(ss + (size_t)row * 16 + 4 * fq);
    float s = (v[0] + v[1]) + (v[2] + v[3]); s += __shfl_xor(s, 16); s += __shfl_xor(s, 32);
    return rsqrtf(s * (1.f / 1024.f) + 1e-6f);
}
__device__ __forceinline__ u32x4 pack8(const f32x4& a, const f32x4& b) { u32x4 w; w.x = cvtpk(a[0], a[1]); w.y = cvtpk(a[2], a[3]); w.z = cvtpk(b[0], b[1]); w.w = cvtpk(b[2], b[3]); return w; }

struct EpiSwiglu {
    static constexpr bool PERM = true;
    const float* ss; bf16_t* hid;
    __device__ __forceinline__ void operator()(const f32x4 (&acc)[2][2][4][2], const Unit& u, int wr, int wc, int fr, int fq) const {
        const int row0 = u.pm * BM + wr * 64 + fr, col0 = u.pn * 128 + wc * 32 + 8 * fq;
#pragma unroll
        for (int ai = 0; ai < 2; ++ai)
#pragma unroll
            for (int m = 0; m < 4; ++m) {
                const int row = row0 + ai * HALF + m * 16; const float rs = rs_from_ss(ss, row, fq);
                f32x4 h[2];
#pragma unroll
                for (int n = 0; n < 2; ++n) { const f32x4 a = acc[ai][0][m][n] * rs, b = acc[ai][1][m][n] * rs;
#pragma unroll
                    for (int i = 0; i < 4; ++i) h[n][i] = a[i] * b[i] * fsigmoid(a[i]); }
                *(u32x4*)(hid + (size_t)row * F_ + col0) = pack8(h[0], h[1]);
            }
    }
};
struct EpiRes {
    static constexpr bool PERM = true;
    const float* resid; float* outf; bf16_t* outb; float* ssout; float coef;
    __device__ __forceinline__ void operator()(const f32x4 (&acc)[2][2][4][2], const Unit& u, int wr, int wc, int fr, int fq) const {
        const int row0 = u.pm * BM + wr * 64 + fr, col0 = u.pn * BM + wc * 32 + 8 * fq;
#pragma unroll
        for (int ai = 0; ai < 2; ++ai)
#pragma unroll
            for (int m = 0; m < 4; ++m) {
                const int row = row0 + ai * HALF + m * 16; float sq = 0.f;
#pragma unroll
                for (int bj = 0; bj < 2; ++bj) {
                    const size_t off = (size_t)row * D_ + col0 + bj * HALF;
                    const f32x4 r0 = *(const f32x4*)(resid + off), r1 = *(const f32x4*)(resid + off + 4);
                    const f32x4 v0 = r0 + acc[ai][bj][m][0] * coef, v1 = r1 + acc[ai][bj][m][1] * coef;
                    *(f32x4*)(outf + off) = v0; *(f32x4*)(outf + off + 4) = v1;
                    *(u32x4*)(outb + off) = pack8(v0, v1);
                    sq += (v0[0] * v0[0] + v0[1] * v0[1]) + (v0[2] * v0[2] + v0[3] * v0[3]) + (v1[0] * v1[0] + v1[1] * v1[1]) + (v1[2] * v1[2] + v1[3] * v1[3]);
                }
                sq += __shfl_xor(sq, 16); sq += __shfl_xor(sq, 32);
                if (fq == 0) ssout[(size_t)row * 16 + u.pn * 4 + wc] = sq;
            }
    }
};
struct EpiInproj {
    static constexpr bool PERM = true;
    const float* ss; bf16_t* Z;
    __device__ __forceinline__ void operator()(const f32x4 (&acc)[2][2][4][2], const Unit& u, int wr, int wc, int fr, int fq) const {
        const int row0 = u.pm * BM + wr * 64 + fr, col0 = u.pn * BM + wc * 32 + 8 * fq;
#pragma unroll
        for (int ai = 0; ai < 2; ++ai)
#pragma unroll
            for (int m = 0; m < 4; ++m) {
                const int row = row0 + ai * HALF + m * 16; const float rs = rs_from_ss(ss, row, fq);
#pragma unroll
                for (int bj = 0; bj < 2; ++bj) {
                    const int col = col0 + bj * HALF;
                    if (col < NIN) {
                        f32x4 v0 = acc[ai][bj][m][0] * rs, v1 = acc[ai][bj][m][1] * rs;
                        if ((col >= ZC_GATE && col < ZC_QM) || col >= ZC_GA) {
#pragma unroll
                            for (int i = 0; i < 4; ++i) { v0[i] = fsigmoid(v0[i]); v1[i] = fsigmoid(v1[i]); }
                        }
                        *(u32x4*)(Z + (size_t)row * ZP + col) = pack8(v0, v1);
                    }
                }
            }
    }
};
template <int PASS> struct EpiUpmix {
    static constexpr bool PERM = true;
    const bf16_t* Z; bf16_t* outb;
    __device__ __forceinline__ void operator()(const f32x4 (&acc)[2][2][4][2], const Unit& u, int wr, int wc, int fr, int fq) const {
        const int row0 = u.pm * BM + wr * 64 + fr, col0 = u.pn * BM + wc * 32 + 8 * fq;
#pragma unroll
        for (int ai = 0; ai < 2; ++ai)
#pragma unroll
            for (int m = 0; m < 4; ++m) {
                const int row = row0 + ai * HALF + m * 16;
#pragma unroll
                for (int bj = 0; bj < 2; ++bj) {
                    const int col = col0 + bj * HALF;
                    const u32x4 gw = *(const u32x4*)(Z + (size_t)row * ZP + (PASS ? ZC_GB : ZC_GA) + col);
                    f32x4 v0, v1;
                    v0[0] = bflo(gw.x) * acc[ai][bj][m][0][0]; v0[1] = bfhi(gw.x) * acc[ai][bj][m][0][1]; v0[2] = bflo(gw.y) * acc[ai][bj][m][0][2]; v0[3] = bfhi(gw.y) * acc[ai][bj][m][0][3];
                    v1[0] = bflo(gw.z) * acc[ai][bj][m][1][0]; v1[1] = bfhi(gw.z) * acc[ai][bj][m][1][1]; v1[2] = bflo(gw.w) * acc[ai][bj][m][1][2]; v1[3] = bfhi(gw.w) * acc[ai][bj][m][1][3];
                    bf16_t* o = outb + (size_t)row * D_ + col;
                    if (PASS) { const u32x4 t = *(const u32x4*)o;
                        v0[0] += bflo(t.x); v0[1] += bfhi(t.x); v0[2] += bflo(t.y); v0[3] += bfhi(t.y); v1[0] += bflo(t.z); v1[1] += bfhi(t.z); v1[2] += bflo(t.w); v1[3] += bfhi(t.w); }
                    *(u32x4*)o = pack8(v0, v1);
                }
            }
    }
};
struct EpiPe {
    static constexpr bool PERM = true;
    float* pe;
    __device__ __forceinline__ void operator()(const f32x4 (&acc)[2][2][4][2], const Unit& u, int wr, int wc, int fr, int fq) const {
        const int row0 = u.pm * BM + wr * 64 + fr, col0 = u.pn * BM + wc * 32 + 8 * fq;
#pragma unroll
        for (int ai = 0; ai < 2; ++ai)
#pragma unroll
            for (int m = 0; m < 4; ++m)
#pragma unroll
                for (int bj = 0; bj < 2; ++bj) { const size_t off = (size_t)(row0 + ai * HALF + m * 16) * D_ + col0 + bj * HALF;
                    *(f32x4*)(pe + off) = acc[ai][bj][m][0]; *(f32x4*)(pe + off + 4) = acc[ai][bj][m][1]; }
    }
};
struct EpiPle {
    static constexpr bool PERM = true;
    const float* ss; const float* pe; float* h; float* ssout;
    __device__ __forceinline__ void operator()(const f32x4 (&acc)[2][2][4][2], const Unit& u, int wr, int wc, int fr, int fq) const {
        const int row0 = u.pm * BM + wr * 64 + fr, col0 = u.pn * BM + wc * 32 + 8 * fq;
#pragma unroll
        for (int ai = 0; ai < 2; ++ai)
#pragma unroll
            for (int m = 0; m < 4; ++m) {
                const int row = row0 + ai * HALF + m * 16; const float rs = rs_from_ss(ss, row, fq); float sq = 0.f;
#pragma unroll
                for (int bj = 0; bj < 2; ++bj) {
                    const size_t off = (size_t)row * D_ + col0 + bj * HALF;
#pragma unroll
                    for (int n = 0; n < 2; ++n) {
                        const f32x4 r = *(const f32x4*)(h + off + 4 * n), p = *(const f32x4*)(pe + off + 4 * n); f32x4 v;
#pragma unroll
                        for (int i = 0; i < 4; ++i) { v[i] = r[i] + fsigmoid(acc[ai][bj][m][n][i] * rs) * p[i]; sq += v[i] * v[i]; }
                        *(f32x4*)(h + off + 4 * n) = v;
                    }
                }
                sq += __shfl_xor(sq, 16); sq += __shfl_xor(sq, 32);
                if (fq == 0) ssout[(size_t)row * 16 + u.pn * 4 + wc] = sq;
            }
    }
};

template <class Epi, class Sched, bool ALIGN_EPI>
__device__ __forceinline__ void gemm_phase(LAS unsigned char* lds, const Gemm g, const Sched& S, const Epi& E) {
    const int tid = threadIdx.x, wid = __builtin_amdgcn_readfirstlane(tid >> 6), lane = tid & 63, wr = wid >> 2, wc = wid & 3, fr = lane & 15, fq = lane >> 4;
    const int K = g.K, nt = K / BK;
    unsigned voffA[2], voffB[2];
#pragma unroll
    for (int i = 0; i < 2; ++i) { int R, C; stage_rc(tid * 16 + i * 8192, R, C); const int Rb = Epi::PERM ? ((R & ~31) + perm32(R & 31)) : R;
        voffA[i] = (unsigned)(R * g.lda + C) * 2u; voffB[i] = (unsigned)(Rb * g.ldb + C) * 2u; }
    const size_t kstep = (size_t)(BK * 2);
    const size_t hstepA = (size_t)HALF * g.lda * 2, hstepB = (size_t)HALF * g.ldb * 2;
    const size_t tstepA = 2 * hstepA, tstepB = 2 * hstepB;
    const unsigned ldsw = (unsigned)wid * 1024u;
    const int aoff = lds_byte(wr * 64 + fr, fq * 8), boff = lds_byte(wc * 32 + fr, fq * 8);
#define PG8_SA(b, h) (((b) * 2 + (h)) * HTB)
#define PG8_SB(b, h) ((4 + (b) * 2 + (h)) * HTB)
#define PG8_STAGE(bufoff, gbase, voff) do { _Pragma("unroll") for (int _i = 0; _i < 2; ++_i) \
        __builtin_amdgcn_global_load_lds((const unsigned*)((const char*)(gbase) + (voff)[_i]), (LAS unsigned*)(lds + (bufoff) + ldsw + _i * 8192), 16, 0, 0); } while (0)
#define PG8_LDA(dst, b, h) do { _Pragma("unroll") for (int m = 0; m < 4; ++m) _Pragma("unroll") for (int k = 0; k < 2; ++k) dst[m][k] = *(const LAS bf16x8*)(lds + PG8_SA(b, h) + aoff + m * 2048 + k * 1024); } while (0)
#define PG8_LDB(dst, b, h) do { _Pragma("unroll") for (int n = 0; n < 2; ++n) _Pragma("unroll") for (int k = 0; k < 2; ++k) dst[n][k] = *(const LAS bf16x8*)(lds + PG8_SB(b, h) + boff + n * 2048 + k * 1024); } while (0)
#define PG8_MMA(ai, bj, At, Bt) do { __builtin_amdgcn_s_setprio(1); _Pragma("unroll") for (int m = 0; m < 4; ++m) _Pragma("unroll") for (int n = 0; n < 2; ++n) _Pragma("unroll") for (int k = 0; k < 2; ++k) \
        acc[ai][bj][m][n] = __builtin_amdgcn_mfma_f32_16x16x32_bf16(Bt[n][k], At[m][k], acc[ai][bj][m][n], 0, 0, 0); __builtin_amdgcn_s_setprio(0); } while (0)
#define PG8_WAIT_V(n) asm volatile("s_waitcnt vmcnt(" #n ")" ::: "memory")
#define PG8_WAIT_L(n) asm volatile("s_waitcnt lgkmcnt(" #n ")" ::: "memory")
#define PG8_BAR __builtin_amdgcn_s_barrier()
#define PG8_SCHED __builtin_amdgcn_sched_barrier(0)
    Unit cur, nxt; int ui = 0;
    if (!S.next(0, cur)) return;
    f32x4 acc[2][2][4][2];
#pragma unroll
    for (int a = 0; a < 2; ++a)
#pragma unroll
        for (int b = 0; b < 2; ++b)
#pragma unroll
            for (int m = 0; m < 4; ++m)
#pragma unroll
                for (int n = 0; n < 2; ++n) acc[a][b][m][n] = (f32x4){0.f, 0.f, 0.f, 0.f};
    bf16x8 At[4][2], B0[2][2], B1[2][2];
    const char* cA = (const char*)g.A + (size_t)cur.pm * tstepA; const char* cB = (const char*)g.Bt + (size_t)cur.pn * tstepB;
    PG8_STAGE(PG8_SB(0, 0), cB, voffB); PG8_STAGE(PG8_SB(0, 1), cB + hstepB, voffB); PG8_STAGE(PG8_SA(0, 0), cA, voffA); PG8_STAGE(PG8_SA(0, 1), cA + hstepA, voffA);
    if (wr == 1) PG8_BAR;
    PG8_WAIT_V(2); PG8_BAR;
    PG8_STAGE(PG8_SB(1, 0), cB + kstep, voffB); PG8_STAGE(PG8_SA(1, 0), cA + kstep, voffA); PG8_STAGE(PG8_SB(1, 1), cB + hstepB + kstep, voffB);
    PG8_WAIT_V(6); PG8_BAR;
    for (;;) {
        const bool has_next = S.next(ui + 1, nxt);
        const char* nA = has_next ? (const char*)g.A + (size_t)nxt.pm * tstepA : cA; const char* nB = has_next ? (const char*)g.Bt + (size_t)nxt.pn * tstepB : cB;
        for (int t = 0; t < nt; t += 2) {
            const bool last = (t == nt - 2);
            const char* a1 = cA + (size_t)(t + 1) * kstep;
            const char* a2 = last ? nA : cA + (size_t)(t + 2) * kstep; const char* b2 = last ? nB : cB + (size_t)(t + 2) * kstep;
            const char* a3 = a2 + kstep; const char* b3 = b2 + kstep;
            PG8_LDB(B0, 0, 0); PG8_LDB(B1, 0, 1); PG8_SCHED; PG8_LDA(At, 0, 0); PG8_STAGE(PG8_SA(1, 1), a1 + hstepA, voffA);
            PG8_WAIT_V(8); PG8_WAIT_L(0); PG8_BAR; PG8_MMA(0, 0, At, B0); PG8_MMA(0, 1, At, B1); PG8_BAR; PG8_SCHED;
            PG8_LDA(At, 0, 1); PG8_STAGE(PG8_SB(0, 0), b2, voffB); PG8_STAGE(PG8_SB(0, 1), b2 + hstepB, voffB); PG8_STAGE(PG8_SA(0, 0), a2, voffA);
            PG8_WAIT_V(8); PG8_WAIT_L(0); PG8_BAR; PG8_MMA(1, 0, At, B0); PG8_MMA(1, 1, At, B1); PG8_BAR; PG8_SCHED;
            PG8_LDB(B0, 1, 0); PG8_LDB(B1, 1, 1); PG8_SCHED; PG8_LDA(At, 1, 0); PG8_STAGE(PG8_SA(0, 1), a2 + hstepA, voffA);
            PG8_WAIT_V(8); PG8_WAIT_L(0); PG8_BAR; PG8_MMA(0, 0, At, B0); PG8_MMA(0, 1, At, B1); PG8_BAR; PG8_SCHED;
            PG8_LDA(At, 1, 1); PG8_STAGE(PG8_SB(1, 0), b3, voffB); PG8_STAGE(PG8_SB(1, 1), b3 + hstepB, voffB); PG8_STAGE(PG8_SA(1, 0), a3, voffA);
            PG8_WAIT_V(8); PG8_WAIT_L(0); PG8_BAR; PG8_MMA(1, 0, At, B0); PG8_MMA(1, 1, At, B1); PG8_BAR; PG8_SCHED;
        }
        if constexpr (ALIGN_EPI) { if (wr == 0) PG8_BAR; }
        E(acc, cur, wr, wc, fr, fq);
        if (!has_next) break;
#pragma unroll
        for (int a = 0; a < 2; ++a)
#pragma unroll
            for (int b = 0; b < 2; ++b)
#pragma unroll
                for (int m = 0; m < 4; ++m)
#pragma unroll
                    for (int n = 0; n < 2; ++n) acc[a][b][m][n] = (f32x4){0.f, 0.f, 0.f, 0.f};
        cur = nxt; cA = nA; cB = nB; ++ui;
        if constexpr (ALIGN_EPI) { if (wr == 1) PG8_BAR; }
    }
    PG8_WAIT_V(0);
    if constexpr (!ALIGN_EPI) { if (wr == 0) PG8_BAR; }
    PG8_BAR;
#undef PG8_SA
#undef PG8_SB
#undef PG8_STAGE
#undef PG8_LDA
#undef PG8_LDB
#undef PG8_MMA
#undef PG8_WAIT_V
#undef PG8_WAIT_L
#undef PG8_BAR
#undef PG8_SCHED
}
}
typedef GAS unsigned gu32;
#define RLX_AGENT __ATOMIC_RELAXED, __HIP_MEMORY_SCOPE_AGENT
#define LDS_WAIT() asm volatile("s_waitcnt lgkmcnt(0)" ::: "memory")
#define VM_WAIT() asm volatile("s_waitcnt vmcnt(0)" ::: "memory")
#define XB_TMO      128
#define XB_XCNT(j)  (256  + 64 * (j))
#define XB_XSUB(j)  (1280 + 64 * (j))
#define XB_XGEN(j)  (2304 + 64 * (j))
#define XB_TOP      3328
#define XB_TOPGEN   3392
#define XCD_BAR_WORDS 3456
#define XB_SPIN_CAP (1u << 20)
constexpr int CW_BAR = 1024;
constexpr int CW_QUEUE = 8192;
static_assert((CW_BAR + XCD_BAR_WORDS) * 4 <= (int)CTL_ZERO_BYTES && (CW_QUEUE + 64 * 8) * 4 <= (int)CTL_ZERO_BYTES, "ctl words inside the memset region");

__device__ __forceinline__ unsigned xb_ld(unsigned* p)              { return __hip_atomic_load(p, __ATOMIC_RELAXED, __HIP_MEMORY_SCOPE_AGENT); }
__device__ __forceinline__ unsigned xb_add(unsigned* p, unsigned v) { return __hip_atomic_fetch_add(p, v, __ATOMIC_RELAXED, __HIP_MEMORY_SCOPE_AGENT); }
__device__ __forceinline__ unsigned xb_xcc_id() { return (unsigned)__builtin_amdgcn_s_getreg((3 << 11) | 20) & 0xFu; }
#define XB_SPIN(cond, bar) do { unsigned _sp = 0; while (cond) { __builtin_amdgcn_s_sleep(1); \
    if ((++_sp & 255u) == 0u) { if (xb_ld(&(bar)[XB_TMO])) break; if (_sp > XB_SPIN_CAP) { atomicAdd(&(bar)[XB_TMO], 1u); break; } } } } while (0)

struct XcdBarrier { unsigned* bar; unsigned x; volatile LAS unsigned* st; };
__device__ __forceinline__ XcdBarrier xcd_barrier_post(unsigned* bar, volatile LAS unsigned* st) {
    XcdBarrier b; b.bar = bar; b.x = xb_xcc_id(); b.st = st;
    if (threadIdx.x == 0) (void)xb_add(&bar[XB_XCNT(b.x)], 1u);
    return b;
}
__device__ __forceinline__ void xcd_barrier_complete(unsigned* bar, unsigned x, unsigned& nloc, unsigned& nx) {
    const unsigned G = gridDim.x * gridDim.y * gridDim.z;
    unsigned sum, cnt, mine, sp = 0u;
    for (;;) {
        sum = 0u; cnt = 0u; mine = 0u;
#pragma unroll
        for (unsigned j = 0; j < 16; ++j) { const unsigned c = xb_ld(&bar[XB_XCNT(j)]); sum += c; cnt += (c > 0u) ? 1u : 0u; mine = (j == x) ? c : mine; }
        if (sum == G) break;
        __builtin_amdgcn_s_sleep(1);
        if ((++sp & 255u) == 0u) { if (xb_ld(&bar[XB_TMO])) break; if (sp > XB_SPIN_CAP) { atomicAdd(&bar[XB_TMO], 1u); break; } }
    }
    nloc = mine > 0u ? mine : 1u; nx = cnt > 0u ? cnt : 1u;
}
__device__ __forceinline__ void xcd_barrier(const XcdBarrier& b) {
    asm volatile("s_waitcnt vmcnt(0)" ::: "memory");
    __syncthreads();
    if (threadIdx.x == 0) {
        unsigned* bar = b.bar;
        __builtin_amdgcn_s_waitcnt(0);
        unsigned nloc = b.st[0], nx = b.st[1];
        if (nloc == 0u) { xcd_barrier_complete(bar, b.x, nloc, nx); b.st[0] = nloc; b.st[1] = nx; }
        const unsigned old = xb_add(&bar[XB_XSUB(b.x)], 1u);
        const unsigned gen = old / nloc;
        if (old + 1u == (gen + 1u) * nloc) {
            __builtin_amdgcn_fence(__ATOMIC_RELEASE, "agent");
            asm volatile("s_waitcnt vmcnt(0)" ::: "memory");
            const unsigned og = xb_add(&bar[XB_TOP], 1u);
            const unsigned tg = og / nx;
            if (og + 1u == (tg + 1u) * nx) xb_add(&bar[XB_TOPGEN], 1u);
            else XB_SPIN(xb_ld(&bar[XB_TOPGEN]) == tg, bar);
            __builtin_amdgcn_fence(__ATOMIC_ACQUIRE, "agent");
            xb_add(&bar[XB_XGEN(b.x)], 1u);
            asm volatile("s_waitcnt vmcnt(0)" ::: "memory");
        } else {
            XB_SPIN(xb_ld(&bar[XB_XGEN(b.x)]) == gen, bar);
            __builtin_amdgcn_fence(__ATOMIC_ACQUIRE, "agent");
            asm volatile("s_waitcnt vmcnt(0)" ::: "memory");
        }
    }
    __syncthreads();
}

struct Args { const float* in[25]; float* out; unsigned char* ws; int ph_lo, ph_hi; };
static_assert(sizeof(Args) == 25 * 8 + 8 + 8 + 8, "no padding");

__device__ __forceinline__ void tr_item(const float* W, const float* gain, bf16_t* Wt, int K, int N, int mode, int roff, bool qscale, LAS float* scr, int item, int lane) {
    const int nblk = (N + 31) >> 5, kb = item / nblk, nb = item - kb * nblk, k0 = 64 * kb, n0 = 32 * nb;
#pragma unroll 8
    for (int i = 0; i < 32; ++i) {
        const int kk = 2 * i + (lane >> 5), n = n0 + (lane & 31);
        float v = 0.f;
        if (n < N) { v = W[(size_t)(k0 + kk) * N + n]; if (gain) v *= gain[k0 + kk]; }
        scr[kk * 33 + (lane & 31)] = v;
    }
    LDS_WAIT(); asm volatile("" ::: "memory");
    const int c = lane & 7;
#pragma unroll
    for (int j = 0; j < 4; ++j) {
        const int nl = (lane >> 3) + 8 * j, n = n0 + nl;
        if (n < N) {
            const LAS float* s = scr + (8 * c) * 33 + nl;
            const float sc = (qscale && ((n >= ZC_QN && n < ZC_QN + 512) || (n >= ZC_QM && n < ZC_QM + 512))) ? C2 : 1.f;
            u32x4 o;
            o.x = pk2(s[0 * 33] * sc, s[1 * 33] * sc); o.y = pk2(s[2 * 33] * sc, s[3 * 33] * sc);
            o.z = pk2(s[4 * 33] * sc, s[5 * 33] * sc); o.w = pk2(s[6 * 33] * sc, s[7 * 33] * sc);
            const int drow = mode ? ((n >> 7) * 256 + (n & 127) + roff) : n;
            *(u32x4*)(Wt + (size_t)drow * K + k0 + 8 * c) = o;
        }
    }
    LDS_WAIT(); asm volatile("" ::: "memory");
}
constexpr int trcnt(int K, int N) { return (K / 64) * ((N + 31) / 32); }
constexpr int I_W13 = trcnt(D_, F_), I_W2 = trcnt(F_, D_), I_WIN = trcnt(D_, NIN), I_WUP = trcnt(512, D_), I_WDD = trcnt(D_, D_), I_WPLE = trcnt(PLE_, D_), I_WC1 = trcnt(2048, 128);
constexpr int TR_NITEMS = 4 * I_W13 + 2 * I_W2 + I_WIN + 2 * I_WUP + 2 * I_WDD + I_WPLE + 2 * I_WC1;

__device__ __forceinline__ void p0_prologue(const Args& a, LAS unsigned char* lds, int vcu, int G, int wave, int lane, int tid) {
    unsigned char* ws = a.ws;
    LAS float* scr = (LAS float*)(lds + wave * 16384);
    const int gw = vcu * NWAVES + wave, NGW = G * NWAVES;
    for (int it = gw; it < TR_NITEMS; it += NGW) {
        int r = it;
        if (r < I_W13) { tr_item(a.in[3], a.in[2], (bf16_t*)(ws + WS_W13A), D_, F_, 1, 0, false, scr, r, lane); continue; } r -= I_W13;
        if (r < I_W13) { tr_item(a.in[4], a.in[2], (bf16_t*)(ws + WS_W13A), D_, F_, 1, 128, false, scr, r, lane); continue; } r -= I_W13;
        if (r < I_W2) { tr_item(a.in[5], nullptr, (bf16_t*)(ws + WS_W2A), F_, D_, 0, 0, false, scr, r, lane); continue; } r -= I_W2;
        if (r < I_W13) { tr_item(a.in[18], a.in[17], (bf16_t*)(ws + WS_W13B), D_, F_, 1, 0, false, scr, r, lane); continue; } r -= I_W13;
        if (r < I_W13) { tr_item(a.in[19], a.in[17], (bf16_t*)(ws + WS_W13B), D_, F_, 1, 128, false, scr, r, lane); continue; } r -= I_W13;
        if (r < I_W2) { tr_item(a.in[20], nullptr, (bf16_t*)(ws + WS_W2B), F_, D_, 0, 0, false, scr, r, lane); continue; } r -= I_W2;
        if (r < I_WIN) { tr_item(a.in[7], a.in[6], (bf16_t*)(ws + WS_WIN), D_, NIN, 0, 0, true, scr, r, lane); continue; } r -= I_WIN;
        if (r < I_WUP) { tr_item(a.in[14], nullptr, (bf16_t*)(ws + WS_WUPN), 512, D_, 0, 0, false, scr, r, lane); continue; } r -= I_WUP;
        if (r < I_WUP) { tr_item(a.in[15], nullptr, (bf16_t*)(ws + WS_WUPM), 512, D_, 0, 0, false, scr, r, lane); continue; } r -= I_WUP;
        if (r < I_WDD) { tr_item(a.in[16], nullptr, (bf16_t*)(ws + WS_WOUT), D_, D_, 0, 0, false, scr, r, lane); continue; } r -= I_WDD;
        if (r < I_WDD) { tr_item(a.in[22], a.in[21], (bf16_t*)(ws + WS_WPG), D_, D_, 0, 0, false, scr, r, lane); continue; } r -= I_WDD;
        if (r < I_WPLE) { tr_item(a.in[23], nullptr, (bf16_t*)(ws + WS_WPLE), PLE_, D_, 0, 0, false, scr, r, lane); continue; } r -= I_WPLE;
        if (r < I_WC1) { tr_item(a.in[9], nullptr, (bf16_t*)(ws + WS_WC1K), 2048, 128, 0, 0, false, scr, r, lane); continue; } r -= I_WC1;
        tr_item(a.in[12], nullptr, (bf16_t*)(ws + WS_WC1V), 2048, 128, 0, 0, false, scr, r, lane);
    }
    { const float* x = a.in[0]; bf16_t* xb = (bf16_t*)(ws + WS_AB); float* ss = (float*)(ws + WS_SS);
      for (int row = gw; row < M_; row += NGW) {
          const f32x4* xr = (const f32x4*)(x + (size_t)row * D_) + lane; u32x2* o = (u32x2*)(xb + (size_t)row * D_) + lane; float s = 0.f;
#pragma unroll
          for (int j = 0; j < 4; ++j) { const f32x4 v = xr[64 * j]; s += (v[0] * v[0] + v[1] * v[1]) + (v[2] * v[2] + v[3] * v[3]); u32x2 w; w.x = cvtpk(v[0], v[1]); w.y = cvtpk(v[2], v[3]); o[64 * j] = w; }
          s = wsum(s);
          if (lane < 16) ss[(size_t)row * 16 + lane] = lane == 0 ? s : 0.f;
      } }
    { const f32x4* p = (const f32x4*)a.in[1]; u32x4* pb = (u32x4*)(ws + WS_PB); const int gt = vcu * NTHR + tid, NGT = G * NTHR;
      for (int i = gt; i < M_ * PLE_ / 8; i += NGT) { const f32x4 u = p[2 * i], v = p[2 * i + 1]; u32x4 o; o.x = cvtpk(u[0], u[1]); o.y = cvtpk(u[2], u[3]); o.z = cvtpk(v[0], v[1]); o.w = cvtpk(v[2], v[3]); pb[i] = o; }
      u32x4* wz = (u32x4*)(ws + WS_WIN + (size_t)NIN * D_ * 2);
      for (int i = gt; i < (NINP - NIN) * D_ * 2 / 16; i += NGT) wz[i] = (u32x4){0u, 0u, 0u, 0u}; }
    if (gw < 256) { const int kv = gw >> 7, j = gw & 127; const float* pos = a.in[kv ? 11 : 8]; const float* w1 = a.in[kv ? 12 : 9]; float s = 0.f;
        for (int i = lane; i < 2048; i += 64) s += pos[i] * w1[(size_t)i * 128 + j];
        s = wsum(s); if (lane == 0) ((float*)(ws + WS_CBIAS))[gw] = s; }
}

__device__ __forceinline__ float gelu_tanh(float x) { const float u = 0.7978845608028654f * (x + 0.044715f * x * x * x); return 0.5f * x * (1.f + tanhf(u)); }
__device__ __forceinline__ float dot64(const LAS float* q, const bf16_t* row) {
    const u32x4* r = (const u32x4*)row; float s = 0.f;
#pragma unroll
    for (int i = 0; i < 8; ++i) { const u32x4 v = r[i]; const LAS float* qq = q + 8 * i;
        s += qq[0] * bflo(v.x) + qq[1] * bfhi(v.x) + qq[2] * bflo(v.y) + qq[3] * bfhi(v.y) + qq[4] * bflo(v.z) + qq[5] * bfhi(v.z) + qq[6] * bflo(v.w) + qq[7] * bfhi(v.w); }
    return s;
}
__device__ __forceinline__ void chunk_step(const LAS float* q, const bf16_t* kbase, const bf16_t* vbase, int kpos0, int t, int kmin, float slope2, int lane, float& m, float& l, float& o) {
    const int kpos = kpos0 + lane; const bool ok = kpos <= t && kpos >= kmin;
    float s = -1e30f;
    if (ok) s = dot64(q, kbase + (size_t)lane * ZP) - slope2 * (float)(t - kpos);
    const float mn = fmaxf(m, wmax(s)); const float alpha = exp2f(m - mn); const float p = ok ? exp2f(s - mn) : 0.f;
    l = l * alpha + wsum(p); o *= alpha; m = mn;
    for (int key = 0; key < 64; ++key) { const float pk = __shfl(p, key); if (pk != 0.f) o += pk * bf2f(vbase[(size_t)key * ZP + lane]); }
}
__device__ __forceinline__ void cmp_phase_simple(const Args& a, LAS unsigned char* lds, int vcu, int G, int tid) {
    unsigned char* ws = a.ws; const bf16_t* Z = (const bf16_t*)(ws + WS_R);
    const int sub = tid >> 7, st = tid & 127;
    LAS float* xin = (LAS float*)lds + sub * 2048; LAS float* hid = (LAS float*)(lds + 32768) + sub * 128;
    for (int it0 = vcu * 4; it0 < 4096; it0 += G * 4) {
        const int it = it0 + sub, kv = it >> 11, bg = (it >> 7) & 15, c = it & 127, b = bg >> 1, g = bg & 1;
        bf16_t* outc = (bf16_t*)(ws + (kv ? WS_VC : WS_KC)) + ((size_t)bg * 128 + c) * 64;
        const int coloff = (kv ? ZC_VCMP : ZC_KCMP) + g * 64;
        if (c < 127) for (int i = st; i < 2048; i += 128) { const int l = i >> 6, d = i & 63; xin[i] = bf2f(Z[((size_t)b * S_ + 16 * c + l) * ZP + coloff + d]); }
        __syncthreads();
        if (c < 127) {
            const bf16_t* w1 = (const bf16_t*)(ws + (kv ? WS_WC1V : WS_WC1K)) + (size_t)st * 2048;
            float acc = ((const float*)(ws + WS_CBIAS))[kv * 128 + st];
            for (int i = 0; i < 2048; i += 8) { const u32x4 w = *(const u32x4*)(w1 + i);
                acc += xin[i] * bflo(w.x) + xin[i + 1] * bfhi(w.x) + xin[i + 2] * bflo(w.y) + xin[i + 3] * bfhi(w.y) + xin[i + 4] * bflo(w.z) + xin[i + 5] * bfhi(w.z) + xin[i + 6] * bflo(w.w) + xin[i + 7] * bfhi(w.w); }
            hid[st] = gelu_tanh(acc);
        }
        __syncthreads();
        if (st < 64) { float s = 0.f; if (c < 127) { const float* w2 = a.in[kv ? 13 : 10]; for (int j = 0; j < 128; ++j) s += hid[j] * w2[j * 64 + st]; } outc[st] = (bf16_t)f2bf(s); }
        __syncthreads();
    }
}
__device__ __forceinline__ void kmean_phase_simple(const Args& a, int vcu, int G, int wave, int lane) {
    const bf16_t* Z = (const bf16_t*)(a.ws + WS_R); float* kmean = (float*)(a.ws + WS_KMEAN);
    for (int it = vcu * NWAVES + wave; it < 512; it += G * NWAVES) {
        const int n = it & 7, h = (it >> 3) & 7, b = it >> 6; float s = 0.f;
        for (int i = 0; i < 256; ++i) s += bf2f(Z[((size_t)b * S_ + 256 * n + i) * ZP + ZC_KM + h * 64 + lane]);
        kmean[(size_t)it * 64 + lane] = s * (1.f / 256.f);
    }
}
__device__ __forceinline__ void nsa_item_simple(bf16_t* Z, const bf16_t* kc, const bf16_t* vc, int b, int t, LAS float* L, int tid) {
    const int lane = tid & 63, h = tid >> 6, g = h >> 2, bg = b * 2 + g;
    LAS float* q_s = L; LAS float* p_s = L + 512; LAS float* imp_s = L + 1536; LAS unsigned* mask_s = (LAS unsigned*)(L + 1600);
    bf16_t* zrow = Z + ((size_t)b * S_ + t) * ZP;
    q_s[h * 64 + lane] = bf2f(zrow[ZC_QN + h * 64 + lane]);
    const float slope2 = exp2f(-(float)(2 * h + 1) * 0.5f) * LOG2E;
    __syncthreads();
    const LAS float* q = q_s + h * 64;
    const int ncv = t >= 31 ? ((t - 31) >> 4) + 1 : 0;
    const bool ok0 = lane < ncv, ok1 = lane + 64 < ncv;
    float s0 = -1e30f, s1 = -1e30f;
    if (ok0) s0 = dot64(q, kc + ((size_t)bg * 128 + lane) * 64) - slope2 * (float)(t - (16 * lane + 31));
    if (ok1) s1 = dot64(q, kc + ((size_t)bg * 128 + lane + 64) * 64) - slope2 * (float)(t - (16 * (lane + 64) + 31));
    const float mc = wmax(fmaxf(s0, s1));
    const float e0 = ok0 ? exp2f(s0 - mc) : 0.f, e1 = ok1 ? exp2f(s1 - mc) : 0.f;
    const float lc = wsum(e0 + e1), inv = 1.f / fmaxf(lc, 1e-30f);
    p_s[h * 128 + lane] = e0 * inv; p_s[h * 128 + lane + 64] = e1 * inv;
    __syncthreads();
    if (tid < 64) {
        const int gg = tid >> 5, j = tid & 31, lo = max(0, 4 * j - 1), hi = min(126, 4 * j + 3); float s = 0.f;
        for (int hh = 0; hh < 4; ++hh) for (int c = lo; c <= hi; ++c) s += p_s[(gg * 4 + hh) * 128 + c];
        imp_s[gg * 32 + j] = s;
    }
    __syncthreads();
    const int cur = t >> 6;
    if (tid < 64) {
        const int gg = lane >> 5, j = lane & 31;
        const bool causal = j <= cur, forced = (j == 0) || (j == cur) || (j == cur - 1);
        const float val = !causal ? -1e30f : (forced ? 1e9f : imp_s[gg * 32 + j]);
        int rank = 0;
        for (int jj = 0; jj < 32; ++jj) {
            const bool cj = jj <= cur, fj = (jj == 0) || (jj == cur) || (jj == cur - 1);
            const float vv = !cj ? -1e30f : (fj ? 1e9f : imp_s[gg * 32 + jj]);
            rank += (vv > val || (vv == val && jj < j)) ? 1 : 0;
        }
        const unsigned long long bal = __ballot(rank < 16 && causal);
        if (lane == 0) { mask_s[0] = (unsigned)bal; mask_s[1] = (unsigned)(bal >> 32); }
    }
    __syncthreads();
    const unsigned mask = mask_s[g];
    float oc = 0.f;
    for (int c = 0; c < ncv; ++c) oc += p_s[h * 128 + c] * bf2f(vc[((size_t)bg * 128 + c) * 64 + lane]);
    const bf16_t* zb = Z + (size_t)b * S_ * ZP;
    float ms = -1e30f, ls = 0.f, os = 0.f;
    for (int j = 0; j <= cur; ++j) {
        if (!((mask >> j) & 1u)) continue;
        chunk_step(q, zb + (size_t)(64 * j) * ZP + ZC_KSLC + g * 64, zb + (size_t)(64 * j) * ZP + ZC_VSLC + g * 64, 64 * j, t, 0, slope2, lane, ms, ls, os);
    }
    float mw = -1e30f, lw = 0.f, ow = 0.f;
    const int kmin = max(0, t - 511);
    for (int k0 = kmin & ~63; k0 <= t; k0 += 64)
        chunk_step(q, zb + (size_t)k0 * ZP + ZC_KWIN + g * 64, zb + (size_t)k0 * ZP + ZC_VWIN + g * 64, k0, t, kmin, slope2, lane, mw, lw, ow);
    const float g0 = bf2f(zrow[ZC_GATE + h * 3 + 0]), g1 = bf2f(zrow[ZC_GATE + h * 3 + 1]), g2 = bf2f(zrow[ZC_GATE + h * 3 + 2]);
    const float o = g0 * oc + g1 * (os / ls) + g2 * (ow / lw);
    zrow[ZC_QN + h * 64 + lane] = (bf16_t)f2bf(o);
    __syncthreads();
}
__device__ __forceinline__ void moba_item_simple(bf16_t* Z, const float* kmean, int b, int t, LAS float* L, int tid) {
    const int lane = tid & 63, h = tid >> 6;
    bf16_t* zrow = Z + ((size_t)b * S_ + t) * ZP;
    const float qv = bf2f(zrow[ZC_QM + h * 64 + lane]);
    L[h * 64 + lane] = qv;
    const float slope2 = exp2f(-(float)(h + 1)) * LOG2E;
    __syncthreads();
    const LAS float* q = L + h * 64;
    const int cur = t >> 8;
    float gs[8];
#pragma unroll
    for (int j = 0; j < 8; ++j) { gs[j] = -1e30f; if (j < cur) gs[j] = wsum(qv * kmean[(((size_t)b * 8 + h) * 8 + j) * 64 + lane]); }
    unsigned sel = 0;
#pragma unroll
    for (int j = 0; j < 8; ++j) {
        int rank = 0;
#pragma unroll
        for (int jj = 0; jj < 8; ++jj) rank += (gs[jj] > gs[j] || (gs[jj] == gs[j] && jj < j)) ? 1 : 0;
        if (j < cur && rank < 3) sel |= 1u << j;
    }
    const bf16_t* zb = Z + (size_t)b * S_ * ZP;
    float m = -1e30f, l = 0.f, o = 0.f;
    for (int j = 0; j < cur; ++j) {
        if (!((sel >> j) & 1u)) continue;
        for (int k0 = 256 * j; k0 < 256 * j + 256; k0 += 64)
            chunk_step(q, zb + (size_t)k0 * ZP + ZC_KM + h * 64, zb + (size_t)k0 * ZP + ZC_VM + h * 64, k0, t, 0, slope2, lane, m, l, o);
    }
    for (int k0 = 256 * cur; k0 <= t; k0 += 64)
        chunk_step(q, zb + (size_t)k0 * ZP + ZC_KM + h * 64, zb + (size_t)k0 * ZP + ZC_VM + h * 64, k0, t, 0, slope2, lane, m, l, o);
    zrow[ZC_QM + h * 64 + lane] = (bf16_t)f2bf(o / l);
    __syncthreads();
}
namespace fa {
constexpr int L_K = 0, L_V = 16384, L_IMPA = 32768  , L_IMPB = L_IMPA + 33792  , L_IMPS = L_IMPB + 33792  , L_SELM = L_IMPS + 8448  ,
              L_MISC = L_SELM + 256  , L_KMEAN = L_MISC + 64  , L_LINV = L_KMEAN + 2048  , L_END = L_LINV + 1024;
static_assert(L_END <= 131072, "attention LDS inside the ring region");
constexpr float THR = 12.f;

__device__ __forceinline__ int crow(int r, int hi) { return (r & 3) + 8 * (r >> 2) + 4 * hi; }
__device__ __forceinline__ float xmax(float v) { auto rr = __builtin_amdgcn_permlane32_swap(__float_as_uint(v), __float_as_uint(v), false, false); return fmaxf(__uint_as_float(rr[0]), __uint_as_float(rr[1])); }
__device__ __forceinline__ float xsum(float v) { auto rr = __builtin_amdgcn_permlane32_swap(__float_as_uint(v), __float_as_uint(v), false, false); return __uint_as_float(rr[0]) + __uint_as_float(rr[1]); }
typedef short v4i16_t __attribute__((ext_vector_type(4)));
typedef short s16x4 __attribute__((ext_vector_type(4)));
__device__ __forceinline__ s16x4 vtr(const LAS unsigned char* p) { return __builtin_bit_cast(s16x4, __builtin_amdgcn_ds_read_tr16_b64_v4i16((LAS v4i16_t*)p)); }

struct StageRegs { u32x4 k, v; };
__device__ __forceinline__ void stage_load(StageRegs& s, const bf16_t* Kb, const bf16_t* Vb, int pitch, int w, int lane) {
    s.k = *(const u32x4*)(Kb + (size_t)lane * pitch + w * 8);
    s.v = *(const u32x4*)(Vb + (size_t)(16 * (w & 3) + (lane >> 2)) * pitch + (w >> 2) * 32 + (lane & 3) * 8);
}
__device__ __forceinline__ void stage_write(const StageRegs& s, LAS unsigned char* L, int buf, int w, int lane) {
    *(LAS u32x4*)(L + L_K + buf * 8192 + w * 1024 + lane * 16) = s.k;
    *(LAS u32x4*)(L + L_V + buf * 8192 + w * 1024 + lane * 16) = s.v;
}
__device__ __forceinline__ f32x16 qk_block(const LAS unsigned char* kslot, int blk, const bf16x8 (&qr)[4], f32x16 c, int r32, int hi) {
    const LAS unsigned char* kb = kslot + hi * 1024 + r32 * 16 + blk * 512;
#pragma unroll
    for (int s = 0; s < 4; ++s) { const bf16x8 kf = *(const LAS bf16x8*)(kb + s * 2048); c = __builtin_amdgcn_mfma_f32_32x32x16_bf16(kf, qr[s], c, 0, 0, 0); }
    return c;
}
__device__ __forceinline__ void pv_step(const LAS unsigned char* vslot, int ks, bf16x8 pf, f32x16& o0, f32x16& o1, int lane) {
    const int hi = lane >> 5;
    const LAS unsigned char* vb = vslot + ((lane >> 4) & 1) * 32 + (lane & 3) * 8 + (4 * hi + ((lane & 15) >> 2)) * 64 + ks * 1024;
    const s16x4 a0 = vtr(vb), a1 = vtr(vb + 512), b0 = vtr(vb + 4096), b1 = vtr(vb + 4096 + 512);
    const bf16x8 v0 = (bf16x8){a0[0], a0[1], a0[2], a0[3], a1[0], a1[1], a1[2], a1[3]}, v1 = (bf16x8){b0[0], b0[1], b0[2], b0[3], b1[0], b1[1], b1[2], b1[3]};
    o0 = __builtin_amdgcn_mfma_f32_32x32x16_bf16(v0, pf, o0, 0, 0, 0);
    o1 = __builtin_amdgcn_mfma_f32_32x32x16_bf16(v1, pf, o1, 0, 0, 0);
}
__device__ __forceinline__ bf16x8 pack_p(const f32x16& p, int base) {
    u32x4 w; w.x = cvtpk(p[base], p[base + 1]); w.y = cvtpk(p[base + 2], p[base + 3]); w.z = cvtpk(p[base + 4], p[base + 5]); w.w = cvtpk(p[base + 6], p[base + 7]);
    return __builtin_bit_cast(bf16x8, w);
}
struct State { float dl, l; f32x16 o0, o1; };
__device__ __forceinline__ void tile_compute(const LAS unsigned char* kslot, const LAS unsigned char* vslot, const bf16x8 (&qr)[4], float slope2, float off0, int mode, int qq, State& st, int lane) {
    const int r32 = lane & 31, hi = lane >> 5;
    f32x16 p0, p1;
    { const float oh0 = off0 + slope2 * (float)(4 * hi), oh1 = oh0 + slope2 * 32.f;
#pragma unroll
      for (int r = 0; r < 16; ++r) { const float cr = (float)((r & 3) + 8 * (r >> 2)); p0[r] = slope2 * cr + oh0; p1[r] = slope2 * cr + oh1; } }
    p0 = qk_block(kslot, 0, qr, p0, r32, hi);
    p1 = qk_block(kslot, 1, qr, p1, r32, hi);
    if (mode) {
        const bool causal = (mode == 1);
#pragma unroll
        for (int r = 0; r < 16; ++r) { const int d0 = crow(r, hi) - qq; if ((d0 <= 0) != causal) p0[r] = -INFINITY; if ((d0 + 32 <= 0) != causal) p1[r] = -INFINITY; }
    }
    float rm = fmaxf(p0[0], p1[0]);
#pragma unroll
    for (int r = 1; r < 16; ++r) rm = fmaxf(rm, fmaxf(p0[r], p1[r]));
    rm = xmax(rm);
    if (__any(rm > THR)) {
        const float d = fmaxf(rm, 0.f), f = __builtin_amdgcn_exp2f(-d);
        st.dl += d; st.l *= f;
#pragma unroll
        for (int r = 0; r < 16; ++r) { p0[r] -= d; p1[r] -= d; st.o0[r] *= f; st.o1[r] *= f; }
    }
    float sm = 0.f;
#pragma unroll
    for (int r = 0; r < 16; ++r) { p0[r] = __builtin_amdgcn_exp2f(p0[r]); p1[r] = __builtin_amdgcn_exp2f(p1[r]); sm += p0[r] + p1[r]; }
    st.l += sm;
    pv_step(vslot, 0, pack_p(p0, 0), st.o0, st.o1, lane);
    pv_step(vslot, 1, pack_p(p0, 8), st.o0, st.o1, lane);
    pv_step(vslot, 2, pack_p(p1, 0), st.o0, st.o1, lane);
    pv_step(vslot, 3, pack_p(p1, 8), st.o0, st.o1, lane);
}
__device__ __forceinline__ void tile_loop(unsigned tm, unsigned lsel, int jdiag, int jfar, const bf16_t* zb, int kcol, int vcol, const bf16x8 (&qr)[4], float slope2, int tq, int qq,
                                          State& st, LAS unsigned char* L, int& buf, int w, int lane) {
    StageRegs sr;
    if (tm) { const int j = 31 - __builtin_clz(tm); stage_load(sr, zb + (size_t)(64 * j) * ZP + kcol, zb + (size_t)(64 * j) * ZP + vcol, ZP, w, lane); }
    __syncthreads();
    while (tm) {
        const int j = 31 - __builtin_clz(tm); tm &= ~(1u << j);
        stage_write(sr, L, buf, w, lane);
        __syncthreads();
        if (tm) { const int jn = 31 - __builtin_clz(tm); stage_load(sr, zb + (size_t)(64 * jn) * ZP + kcol, zb + (size_t)(64 * jn) * ZP + vcol, ZP, w, lane); }
        if (j <= jdiag) {
            const int mode = (j == jdiag) ? 1 : ((j == jfar) ? 2 : 0);
            const float off0 = ((lsel >> j) & 1u) ? (slope2 * (float)(64 * j - tq) - st.dl) : -1e30f;
            tile_compute(L + L_K + buf * 8192, L + L_V + buf * 8192, qr, slope2, off0, mode, qq, st, lane);
        }
        buf ^= 1;
    }
}
__device__ __forceinline__ void store_o(bf16_t* dst  , const f32x16& o0, const f32x16& o1, int hi) {
#pragma unroll
    for (int rr = 0; rr < 4; ++rr) {
        u32x2 a; a.x = cvtpk(o0[4 * rr], o0[4 * rr + 1]); a.y = cvtpk(o0[4 * rr + 2], o0[4 * rr + 3]); *(u32x2*)(dst + 8 * rr + 4 * hi) = a;
        u32x2 c; c.x = cvtpk(o1[4 * rr], o1[4 * rr + 1]); c.y = cvtpk(o1[4 * rr + 2], o1[4 * rr + 3]); *(u32x2*)(dst + 32 + 8 * rr + 4 * hi) = c;
    }
}

__device__ __forceinline__ void nsa_unit(bf16_t* Z, const bf16_t* kc, const bf16_t* vc, int b, int g, int qt, LAS unsigned char* L, int tid_) {
    int tid = tid_; asm volatile("" : "+v"(tid));
    const int lane = tid & 63, w = __builtin_amdgcn_readfirstlane(tid >> 6), r32 = lane & 31, hi = lane >> 5, hg = w >> 1, half = w & 1, h = 4 * g + hg, bg = 2 * b + g;
    const int qq = 32 * half + r32, tq = 64 * qt + qq;
    bf16_t* zrowq = Z + ((size_t)b * S_ + tq) * ZP;
    const bf16_t* zb = Z + (size_t)b * S_ * ZP;
    bf16x8 qr[4];
#pragma unroll
    for (int s = 0; s < 4; ++s) qr[s] = *(const bf16x8*)(zrowq + ZC_QN + h * 64 + 16 * s + 8 * hi);
    const float slope2 = exp2f(-(float)(2 * h + 1) * 0.5f) * LOG2E;
    const float g0 = bf2f(zrowq[ZC_GATE + h * 3 + 0]), g1 = bf2f(zrowq[ZC_GATE + h * 3 + 1]), g2 = bf2f(zrowq[ZC_GATE + h * 3 + 2]);
    f32x16 acc0, acc1;
    const int nc = min(4 * qt + 3, 127), nblk = (nc + 31) >> 5;
    {
        StageRegs s0, s1;
        const bf16_t* kcb = kc + (size_t)bg * 128 * 64; const bf16_t* vcb = vc + (size_t)bg * 128 * 64;
        stage_load(s0, kcb, vcb, 64, w, lane);
        if (nblk > 2) stage_load(s1, kcb + 64 * 64, vcb + 64 * 64, 64, w, lane);
        __syncthreads();
        stage_write(s0, L, 0, w, lane);
        if (nblk > 2) stage_write(s1, L, 1, w, lane);
        __syncthreads();
    }
    const int cmaxq = (tq - 31) >> 4;
    const float s16 = 16.f * slope2;
    float rm = -INFINITY;
#pragma unroll
    for (int blk = 0; blk < 4; ++blk) if (blk < nblk) {
        const float oh = slope2 * (float)(16 * 32 * blk + 31 - tq) + s16 * (float)(4 * hi);
        f32x16 c;
#pragma unroll
        for (int r = 0; r < 16; ++r) c[r] = s16 * (float)((r & 3) + 8 * (r >> 2)) + oh;
        c = qk_block(L + L_K + (blk >> 1) * 8192, blk & 1, qr, c, r32, hi);
#pragma unroll
        for (int r = 0; r < 16; ++r) { if (32 * blk + crow(r, hi) <= cmaxq) rm = fmaxf(rm, c[r]); }
    }
    rm = xmax(rm); if (rm == -INFINITY) rm = 0.f;
    const bool need_imp = qt >= 16;
    LAS float* impA = (LAS float*)(L + L_IMPA) + (hg * 64 + qq) * 33;
    LAS float* impB = (LAS float*)(L + L_IMPB) + (hg * 64 + qq) * 33;
    float lsum = 0.f;
    {
        f32x16 o0, o1;
#pragma unroll
        for (int r = 0; r < 16; ++r) { o0[r] = 0.f; o1[r] = 0.f; }
#pragma unroll
        for (int blk = 0; blk < 4; ++blk) {
            if (blk < nblk) {
                const float oh = slope2 * (float)(16 * 32 * blk + 31 - tq) + s16 * (float)(4 * hi) - rm;
                f32x16 c;
#pragma unroll
                for (int r = 0; r < 16; ++r) c[r] = s16 * (float)((r & 3) + 8 * (r >> 2)) + oh;
                c = qk_block(L + L_K + (blk >> 1) * 8192, blk & 1, qr, c, r32, hi);
#pragma unroll
                for (int r = 0; r < 16; ++r) { const float e = (32 * blk + crow(r, hi) <= cmaxq) ? __builtin_amdgcn_exp2f(c[r]) : 0.f; c[r] = e; lsum += e; }
                pv_step(L + L_V + (blk >> 1) * 8192, 2 * (blk & 1), pack_p(c, 0), o0, o1, lane);
                pv_step(L + L_V + (blk >> 1) * 8192, 2 * (blk & 1) + 1, pack_p(c, 8), o0, o1, lane);
                if (need_imp) {
#pragma unroll
                    for (int rr = 0; rr < 4; ++rr) { const int j = 8 * blk + 2 * rr + hi; impA[j] = (c[4 * rr] + c[4 * rr + 1]) + (c[4 * rr + 2] + c[4 * rr + 3]); if (j + 1 < 32) impB[j + 1] = c[4 * rr + 3]; }
                }
            } else if (need_imp) {
#pragma unroll
                for (int rr = 0; rr < 4; ++rr) { const int j = 8 * blk + 2 * rr + hi; impA[j] = 0.f; if (j + 1 < 32) impB[j + 1] = 0.f; }
            }
        }
        lsum = xsum(lsum);
        const float inv = lsum > 0.f ? 1.f / lsum : 0.f;
        if (need_imp && hi == 0) { ((LAS float*)(L + L_LINV))[hg * 64 + qq] = inv; impB[0] = 0.f; }
        const float sc = g0 * inv;
#pragma unroll
        for (int r = 0; r < 16; ++r) { acc0[r] = sc * o0[r]; acc1[r] = sc * o1[r]; }
    }
    LAS unsigned* selm = (LAS unsigned*)(L + L_SELM);
    if (need_imp) {
        __syncthreads();
        LAS float* impS = (LAS float*)(L + L_IMPS);
        int tid2 = tid; asm volatile("" : "+v"(tid2));
        { const LAS float* A = (const LAS float*)(L + L_IMPA); const LAS float* Bq = (const LAS float*)(L + L_IMPB); const LAS float* LI = (const LAS float*)(L + L_LINV);
#pragma unroll
          for (int k = 0; k < 4; ++k) { const int idx = tid2 + 512 * k, q2 = idx >> 5, j = idx & 31; float sacc = 0.f;
#pragma unroll
              for (int hh = 0; hh < 4; ++hh) sacc += (A[(hh * 64 + q2) * 33 + j] + Bq[(hh * 64 + q2) * 33 + j]) * LI[hh * 64 + q2];
              impS[q2 * 33 + j] = sacc; } }
        __syncthreads();
        { const int q2 = tid2 >> 3, jg = tid2 & 7; const LAS float* row = impS + q2 * 33; unsigned bits = 0u;
#pragma unroll
          for (int jj = 0; jj < 4; ++jj) { const int j = 4 * jg + jj; bool sel = false;
              if (j == 0 || j == qt || j == qt - 1) sel = true;
              else if (j <= qt - 2) { const float v = row[j]; int rank = 0; for (int j2 = 1; j2 <= qt - 2; ++j2) { const float v2 = row[j2]; rank += (v2 > v || (v2 == v && j2 < j)) ? 1 : 0; } sel = rank < 13; }
              bits |= sel ? (1u << j) : 0u; }
          bits |= __shfl_xor(bits, 1); bits |= __shfl_xor(bits, 2); bits |= __shfl_xor(bits, 4);
          if (jg == 0) selm[q2] = bits; }
        __syncthreads();
    } else {
        if (tid < 64) selm[tid] = (2u << qt) - 1u;
        __syncthreads();
    }
    const unsigned myselm = selm[qq];
    unsigned uni = selm[lane];
#pragma unroll
    for (int o = 32; o > 0; o >>= 1) uni |= __shfl_xor(uni, o);
    uni = __builtin_amdgcn_readfirstlane(uni);
    int buf = 0;
    {
        State st; st.dl = 0.f; st.l = 0.f;
#pragma unroll
        for (int r = 0; r < 16; ++r) { st.o0[r] = 0.f; st.o1[r] = 0.f; }
        tile_loop(uni, myselm, qt, -1, zb, ZC_KSLC + g * 64, ZC_VSLC + g * 64, qr, slope2, tq, qq, st, L, buf, w, lane);
        const float sc = g1 / xsum(st.l);
#pragma unroll
        for (int r = 0; r < 16; ++r) { acc0[r] += sc * st.o0[r]; acc1[r] += sc * st.o1[r]; }
    }
    {
        State st; st.dl = 0.f; st.l = 0.f;
#pragma unroll
        for (int r = 0; r < 16; ++r) { st.o0[r] = 0.f; st.o1[r] = 0.f; }
        const int jlo = max(0, qt - 8); const unsigned tm = ((2u << qt) - 1u) & ~((1u << jlo) - 1u);
        tile_loop(tm, 0xffffffffu, qt, qt - 8, zb, ZC_KWIN + g * 64, ZC_VWIN + g * 64, qr, slope2, tq, qq, st, L, buf, w, lane);
        const float sc = g2 / xsum(st.l);
#pragma unroll
        for (int r = 0; r < 16; ++r) { acc0[r] += sc * st.o0[r]; acc1[r] += sc * st.o1[r]; }
    }
    store_o(zrowq + ZC_QN + h * 64, acc0, acc1, hi);
    __syncthreads();
}

__device__ __forceinline__ void moba_unit(bf16_t* Z, const float* kmean, int b, int h, int nb, LAS unsigned char* L, int tid_) {
    int tid = tid_; asm volatile("" : "+v"(tid));
    const int lane = tid & 63, w = __builtin_amdgcn_readfirstlane(tid >> 6), r32 = lane & 31, hi = lane >> 5;
    const int qq = 32 * (w & 1) + r32, tq = 256 * nb + 32 * w + r32;
    bf16_t* zrowq = Z + ((size_t)b * S_ + tq) * ZP;
    const bf16_t* zb = Z + (size_t)b * S_ * ZP;
    bf16x8 qr[4];
#pragma unroll
    for (int s = 0; s < 4; ++s) qr[s] = *(const bf16x8*)(zrowq + ZC_QM + h * 64 + 16 * s + 8 * hi);
    const float slope2 = exp2f(-(float)(h + 1)) * LOG2E;
    LAS float* km = (LAS float*)(L + L_KMEAN); LAS unsigned* misc = (LAS unsigned*)(L + L_MISC);
    km[tid] = kmean[((size_t)b * 8 + h) * 512 + tid];
    if (tid == 0) misc[1] = 0u;
    __syncthreads();
    unsigned lsel = 0u;
    if (nb > 0) {
        float gs[8];
#pragma unroll
        for (int j = 0; j < 8; ++j) {
            float s = 0.f;
            if (j < nb) {
#pragma unroll
                for (int sI = 0; sI < 4; ++sI) { const u32x4 qw = __builtin_bit_cast(u32x4, qr[sI]); const LAS float* kk = km + j * 64 + 16 * sI + 8 * hi;
                    s += bflo(qw.x) * kk[0] + bfhi(qw.x) * kk[1] + bflo(qw.y) * kk[2] + bfhi(qw.y) * kk[3] + bflo(qw.z) * kk[4] + bfhi(qw.z) * kk[5] + bflo(qw.w) * kk[6] + bfhi(qw.w) * kk[7]; }
                s = xsum(s);
            } else s = -1e30f;
            gs[j] = s;
        }
        unsigned bsel = 0u;
#pragma unroll
        for (int j = 0; j < 8; ++j) { int rank = 0;
#pragma unroll
            for (int j2 = 0; j2 < 8; ++j2) rank += (gs[j2] > gs[j] || (gs[j2] == gs[j] && j2 < j)) ? 1 : 0;
            if (j < nb && rank < 3) bsel |= 1u << j; }
#pragma unroll
        for (int j = 0; j < 8; ++j) if ((bsel >> j) & 1u) lsel |= 0xfu << (4 * j);
        unsigned u = bsel;
#pragma unroll
        for (int o = 32; o > 0; o >>= 1) u |= __shfl_xor(u, o);
        if (lane == 0) (void)__hip_atomic_fetch_or(misc + 1, u, __ATOMIC_RELAXED, __HIP_MEMORY_SCOPE_WORKGROUP);
    }
    __syncthreads();
    unsigned ub = misc[1]; ub = __builtin_amdgcn_readfirstlane(ub);
    unsigned tm = 0xfu << (4 * nb);
#pragma unroll
    for (int j = 0; j < 8; ++j) if ((ub >> j) & 1u) tm |= 0xfu << (4 * j);
    lsel |= 0xfu << (4 * nb);
    State st; st.dl = 0.f; st.l = 0.f;
#pragma unroll
    for (int r = 0; r < 16; ++r) { st.o0[r] = 0.f; st.o1[r] = 0.f; }
    int buf = 0;
    tile_loop(tm, lsel, 4 * nb + (w >> 1), -1, zb, ZC_KM + h * 64, ZC_VM + h * 64, qr, slope2, tq, qq, st, L, buf, w, lane);
    const float sc = 1.f / xsum(st.l);
#pragma unroll
    for (int r = 0; r < 16; ++r) { st.o0[r] *= sc; st.o1[r] *= sc; }
    store_o(zrowq + ZC_QM + h * 64, st.o0, st.o1, hi);
    __syncthreads();
}

__device__ __forceinline__ void attn_phase(bf16_t* Z, const bf16_t* kc, const bf16_t* vc, const float* kmean, unsigned* qhead, LAS unsigned char* L, int tid) {
    LAS unsigned* misc = (LAS unsigned*)(L + L_MISC);
    for (;;) {
        if (tid == 0) misc[0] = atomicAdd(qhead, 1u);
        __syncthreads();
        int u = (int)misc[0]; u = __builtin_amdgcn_readfirstlane(u);
        __syncthreads();
        if (u >= 1024) break;
        int lv = 31;
        for (;; --lv) { const int cnt = 16 + ((lv & 3) == 3 ? 64 : 0); if (u < cnt) break; u -= cnt; }
        if (u < 16) nsa_unit(Z, kc, vc, u >> 1, u & 1, lv, L, tid);
        else { u -= 16; moba_unit(Z, kmean, u >> 3, u & 7, lv >> 2, L, tid); }
    }
}
}
constexpr int RING_OFF = 0, RING_BYTES = 131072;
constexpr int MISC_OFF = RING_BYTES;
constexpr int LDS_BYTES = 147456;
constexpr int N_PHASES = 12;

__global__ void __launch_bounds__(NTHR, 2) mega(Args args) {
    extern __shared__ __attribute__((aligned(16))) unsigned char lds_raw[];
    LAS unsigned char* lds = (LAS unsigned char*)lds_raw;
    const int tid = threadIdx.x, lane = tid & 63, wave = __builtin_amdgcn_readfirstlane(tid >> 6);
    const int G = gridDim.x, bx = blockIdx.x;
    const int vcu = (G % 8 == 0) ? (bx % 8) * (G / 8) + bx / 8 : bx;
    volatile LAS unsigned* MISC = (volatile LAS unsigned*)(lds + MISC_OFF);
    if (tid < 32) MISC[tid] = 0u;
    __syncthreads();
    unsigned char* ws = args.ws;
    const int lo = args.ph_lo, hi = args.ph_hi;
    XcdBarrier bar; bar.bar = (unsigned*)(ws + WS_CTL) + CW_BAR; bar.x = 0; bar.st = MISC + 8;
    if (hi - lo > 1) bar = xcd_barrier_post((unsigned*)(ws + WS_CTL) + CW_BAR, MISC + 8);
#define IN(k) (lo <= (k) && (k) < hi)
#define SEAM(k) do { if (IN(k) && IN((k) + 1)) xcd_barrier(bar); } while (0)
    float* out = args.out;
    bf16_t* AB = (bf16_t*)(ws + WS_AB); bf16_t* AB2 = (bf16_t*)(ws + WS_AB2); bf16_t* HID = (bf16_t*)(ws + WS_R); bf16_t* Z = (bf16_t*)(ws + WS_R); float* PE = (float*)(ws + WS_R);
    float* SS1 = (float*)(ws + WS_SS); float* SS2 = (float*)(ws + WS_SS + SZ_SS); float* SS3 = (float*)(ws + WS_SS + 2 * SZ_SS); float* SS4 = (float*)(ws + WS_SS + 3 * SZ_SS); float* SS5 = (float*)(ws + WS_SS + 4 * SZ_SS);

    if (IN(0)) { p0_prologue(args, lds, vcu, G, wave, lane, tid); SEAM(0); }
    if (IN(1)) { pg8::Gemm g{AB, (const bf16_t*)(ws + WS_W13A), D_, D_, M_, 2 * F_, D_}; pg8::StaticOrder S; S.init(M_, 2 * F_, G, bx);
        pg8::EpiSwiglu E{SS1, HID}; pg8::gemm_phase<pg8::EpiSwiglu, pg8::StaticOrder, true>(lds + RING_OFF, g, S, E); SEAM(1); }
    if (IN(2)) { pg8::Gemm g{HID, (const bf16_t*)(ws + WS_W2A), F_, F_, M_, D_, F_}; pg8::StaticOrder S; S.init(M_, D_, G, bx);
        pg8::EpiRes E{args.in[0], out, AB, SS2, 0.5f}; pg8::gemm_phase<pg8::EpiRes, pg8::StaticOrder, false>(lds + RING_OFF, g, S, E); SEAM(2); }
    if (IN(3)) { pg8::Gemm g{AB, (const bf16_t*)(ws + WS_WIN), D_, D_, M_, NINP, D_}; pg8::StaticOrder S; S.init(M_, NINP, G, bx);
        pg8::EpiInproj E{SS2, Z}; pg8::gemm_phase<pg8::EpiInproj, pg8::StaticOrder, true>(lds + RING_OFF, g, S, E); SEAM(3); }
    if (IN(4)) { cmp_phase_simple(args, lds, vcu, G, tid); kmean_phase_simple(args, vcu, G, wave, lane); SEAM(4); }
    if (IN(5)) {
        const bf16_t* kc = (const bf16_t*)(ws + WS_KC); const bf16_t* vc = (const bf16_t*)(ws + WS_VC); const float* kmean = (const float*)(ws + WS_KMEAN);
#if defined(ATTN_GOLDEN)
        for (int it = vcu; it < M_; it += G) { nsa_item_simple(Z, kc, vc, it >> 11, it & 2047, (LAS float*)lds, tid); moba_item_simple(Z, kmean, it >> 11, it & 2047, (LAS float*)lds, tid); }
#else
        fa::attn_phase(Z, kc, vc, kmean, (unsigned*)(ws + WS_CTL) + CW_QUEUE, lds, tid);
#endif
        SEAM(5); }
    if (IN(6)) {
        { pg8::Gemm g{Z + ZC_QN, (const bf16_t*)(ws + WS_WUPN), ZP, 512, M_, D_, 512}; pg8::StaticOrder S; S.init(M_, D_, G, bx);
          pg8::EpiUpmix<0> E{Z, AB}; pg8::gemm_phase<pg8::EpiUpmix<0>, pg8::StaticOrder, false>(lds + RING_OFF, g, S, E); }
        { pg8::Gemm g{Z + ZC_QM, (const bf16_t*)(ws + WS_WUPM), ZP, 512, M_, D_, 512}; pg8::StaticOrder S; S.init(M_, D_, G, bx);
          pg8::EpiUpmix<1> E{Z, AB}; pg8::gemm_phase<pg8::EpiUpmix<1>, pg8::StaticOrder, false>(lds + RING_OFF, g, S, E); }
        SEAM(6); }
    if (IN(7)) { pg8::Gemm g{AB, (const bf16_t*)(ws + WS_WOUT), D_, D_, M_, D_, D_}; pg8::StaticOrder S; S.init(M_, D_, G, bx);
        pg8::EpiRes E{out, out, AB2, SS3, 1.0f}; pg8::gemm_phase<pg8::EpiRes, pg8::StaticOrder, false>(lds + RING_OFF, g, S, E); SEAM(7); }
    if (IN(8)) { pg8::Gemm g{AB2, (const bf16_t*)(ws + WS_W13B), D_, D_, M_, 2 * F_, D_}; pg8::StaticOrder S; S.init(M_, 2 * F_, G, bx);
        pg8::EpiSwiglu E{SS3, HID}; pg8::gemm_phase<pg8::EpiSwiglu, pg8::StaticOrder, true>(lds + RING_OFF, g, S, E); SEAM(8); }
    if (IN(9)) { pg8::Gemm g{HID, (const bf16_t*)(ws + WS_W2B), F_, F_, M_, D_, F_}; pg8::StaticOrder S; S.init(M_, D_, G, bx);
        pg8::EpiRes E{out, out, AB, SS4, 0.5f}; pg8::gemm_phase<pg8::EpiRes, pg8::StaticOrder, false>(lds + RING_OFF, g, S, E); SEAM(9); }
    if (IN(10)) {
        { pg8::Gemm g{(const bf16_t*)(ws + WS_PB), (const bf16_t*)(ws + WS_WPLE), PLE_, PLE_, M_, D_, PLE_}; pg8::StaticOrder S; S.init(M_, D_, G, bx);
          pg8::EpiPe E{PE}; pg8::gemm_phase<pg8::EpiPe, pg8::StaticOrder, false>(lds + RING_OFF, g, S, E); }
        { pg8::Gemm g{AB, (const bf16_t*)(ws + WS_WPG), D_, D_, M_, D_, D_}; pg8::StaticOrder S; S.init(M_, D_, G, bx);
          pg8::EpiPle E{SS4, PE, out, SS5}; pg8::gemm_phase<pg8::EpiPle, pg8::StaticOrder, false>(lds + RING_OFF, g, S, E); }
        SEAM(10); }
    if (IN(11)) {
        const f32x4* gn = (const f32x4*)args.in[24] + lane;
        for (int row = vcu * NWAVES + wave; row < M_; row += G * NWAVES) {
            const float rs = pg8::rs_from_ss(SS5, row, lane >> 4);
            f32x4* hr = (f32x4*)(out + (size_t)row * D_) + lane;
#pragma unroll
            for (int j = 0; j < 4; ++j) { f32x4 v = hr[64 * j]; const f32x4 gg = gn[64 * j]; v = v * gg * rs; hr[64 * j] = v; }
        }
    }
#undef IN
#undef SEAM
}
}

extern "C" void kernel_launch(void* const* d_in, const int* in_sizes, int n_in, void* d_out, int out_size, void* d_ws, size_t ws_size, hipStream_t stream) {
    static int grid = 0;
    if (grid == 0) {
        if (n_in != 25 || ws_size < WS_END || out_size != M_ * D_) { fprintf(stderr, "kernel_launch: unexpected n_in %d / out_size %d / ws_size %zu (need %zu)\n", n_in, out_size, ws_size, (size_t)WS_END); grid = -1; return; }
        int dev = 0, cus = 0, per_cu = 0;
        if (hipGetDevice(&dev) != hipSuccess || hipDeviceGetAttribute(&cus, hipDeviceAttributeMultiprocessorCount, dev) != hipSuccess) { grid = -1; return; }
        if (hipFuncSetAttribute((const void*)mega, hipFuncAttributeMaxDynamicSharedMemorySize, LDS_BYTES) != hipSuccess) { fprintf(stderr, "kernel_launch: hipFuncSetAttribute failed\n"); grid = -1; return; }
        if (hipOccupancyMaxActiveBlocksPerMultiprocessor(&per_cu, (const void*)mega, NTHR, LDS_BYTES) != hipSuccess || per_cu < 1) fprintf(stderr, "kernel_launch: occupancy query reports %d\n", per_cu);
        (void)hipGetLastError();
        grid = cus;
    }
    if (grid < 0) return;
    (void)hipMemsetAsync((char*)d_ws + WS_CTL, 0, CTL_ZERO_BYTES, stream);
    Args a{};
    for (int i = 0; i < 25; ++i) a.in[i] = (const float*)d_in[i];
    a.out = (float*)d_out; a.ws = (unsigned char*)d_ws;
#if MK_N_LAUNCHES == 1
    a.ph_lo = 0; a.ph_hi = N_PHASES;
    hipLaunchKernelGGL(mega, dim3(grid), dim3(NTHR), LDS_BYTES, stream, a);
#else
    for (int k = 0; k < N_PHASES; ++k) { a.ph_lo = k; a.ph_hi = k + 1; hipLaunchKernelGGL(mega, dim3(grid), dim3(NTHR), LDS_BYTES, stream, a); }
#endif
}
```

```cpp
#include <hip/hip_runtime.h>
#include <cstdint>
#include <cstdio>

#ifndef PROBE_DUP
#define PROBE_DUP -1
#endif
#ifndef MK_N_LAUNCHES
#define MK_N_LAUNCHES 1
#endif

namespace {
typedef unsigned short bf16_t;
#define LAS __attribute__((address_space(3)))
#define GAS __attribute__((address_space(1)))
typedef short bf16x8 __attribute__((ext_vector_type(8)));
typedef float f32x4 __attribute__((ext_vector_type(4)));
typedef float f32x16 __attribute__((ext_vector_type(16)));
typedef unsigned u32x4 __attribute__((ext_vector_type(4)));
typedef unsigned u32x2 __attribute__((ext_vector_type(2)));

constexpr int B_ = 8, S_ = 2048, D_ = 1024, M_ = B_ * S_;
constexpr int F_ = 2816, NIN = 4888, NINP = 5120, PLE_ = 256;
constexpr int ZP = NIN;
constexpr int ZC_QN = 0, ZC_KCMP = 512, ZC_VCMP = 640, ZC_KSLC = 768, ZC_VSLC = 896, ZC_KWIN = 1024, ZC_VWIN = 1152,
              ZC_GATE = 1280, ZC_QM = 1304, ZC_KM = 1816, ZC_VM = 2328, ZC_GA = 2840, ZC_GB = 3864;
constexpr float LOG2E = 1.4426950408889634f;
constexpr float C2 = 0.125f * LOG2E;
constexpr int NWAVES = 8, NTHR = 512;

constexpr size_t MiB = 1u << 20;
constexpr size_t WS_CTL = 0, CTL_ZERO_BYTES = 64 * 1024;
constexpr size_t WS_W13A = 1 * MiB;
constexpr size_t SZ_W13 = (size_t)2 * F_ * D_ * 2, SZ_W2 = (size_t)D_ * F_ * 2;
constexpr size_t WS_W2A = WS_W13A + SZ_W13;
constexpr size_t WS_W13B = WS_W2A + SZ_W2;
constexpr size_t WS_W2B = WS_W13B + SZ_W13;
constexpr size_t WS_WIN = WS_W2B + SZ_W2;
constexpr size_t WS_WUPN = WS_WIN + (size_t)NINP * D_ * 2;
constexpr size_t WS_WUPM = WS_WUPN + (size_t)D_ * 512 * 2;
constexpr size_t WS_WOUT = WS_WUPM + (size_t)D_ * 512 * 2;
constexpr size_t WS_WPG = WS_WOUT + (size_t)D_ * D_ * 2;
constexpr size_t WS_WPLE = WS_WPG + (size_t)D_ * D_ * 2;
constexpr size_t WS_WC1K = WS_WPLE + (size_t)D_ * PLE_ * 2;
constexpr size_t WS_WC1V = WS_WC1K + (size_t)128 * 2048 * 2;
constexpr size_t WS_CBIAS = WS_WC1V + (size_t)128 * 2048 * 2;
constexpr size_t WS_KC = WS_CBIAS + 4096;
constexpr size_t WS_VC = WS_KC + (size_t)16 * 128 * 64 * 2;
constexpr size_t WS_KMEAN = WS_VC + (size_t)16 * 128 * 64 * 2;
constexpr size_t WS_SS = WS_KMEAN + (size_t)8 * 8 * 8 * 64 * 4;
constexpr size_t SZ_SS = (size_t)M_ * 16 * 4;
constexpr size_t WS_AB = WS_SS + 5 * SZ_SS;
constexpr size_t WS_PB = WS_AB + (size_t)M_ * D_ * 2;
constexpr size_t WS_R = WS_PB + (size_t)M_ * PLE_ * 2;
constexpr size_t SZ_Z = (size_t)M_ * ZP * 2, SZ_HID = (size_t)M_ * F_ * 2;
constexpr size_t WS_AB2 = WS_R + SZ_HID;
constexpr size_t WS_END = WS_R + SZ_Z;
static_assert(WS_AB2 + (size_t)M_ * D_ * 2 <= WS_END, "AB2 inside R");
static_assert((size_t)M_ * D_ * 4 <= SZ_Z, "pe temp inside R");
static_assert(WS_END <= 256 * MiB, "workspace map must fit 256 MiB");
static_assert((WS_R % 256) == 0 && (WS_AB % 256) == 0 && (WS_KC % 256) == 0 && (WS_SS % 256) == 0, "alignment");

__device__ __forceinline__ float bf2f(bf16_t v) { return __uint_as_float(((unsigned)v) << 16); }
__device__ __forceinline__ float bflo(unsigned u) { return __uint_as_float(u << 16); }
__device__ __forceinline__ float bfhi(unsigned u) { return __uint_as_float(u & 0xffff0000u); }
__device__ __forceinline__ unsigned f2bf(float f) { unsigned u = __float_as_uint(f); return (u + 0x7fffu + ((u >> 16) & 1u)) >> 16; }
__device__ __forceinline__ unsigned pk2(float lo, float hi) { return f2bf(lo) | (f2bf(hi) << 16); }
typedef float f32x2_t __attribute__((ext_vector_type(2)));
typedef __bf16 bf16x2_t __attribute__((ext_vector_type(2)));
__device__ __forceinline__ unsigned cvtpk(float lo, float hi) { f32x2_t v = {lo, hi}; bf16x2_t b = __builtin_convertvector(v, bf16x2_t); return __builtin_bit_cast(unsigned, b); }
__device__ __forceinline__ float wsum(float v) {
#pragma unroll
    for (int o = 32; o > 0; o >>= 1) v += __shfl_xor(v, o);
    return v;
}
__device__ __forceinline__ float wmax(float v) {
#pragma unroll
    for (int o = 32; o > 0; o >>= 1) v = fmaxf(v, __shfl_xor(v, o));
    return v;
}
__device__ __forceinline__ float fsigmoid(float x) { return __builtin_amdgcn_rcpf(1.f + __builtin_amdgcn_exp2f(-LOG2E * x)); }
namespace pg8 {
constexpr int BM = 256, BK = 64, HALF = 128, HTB = HALF * BK * 2  , STAGE_BYTES = 8 * HTB, NXCD = 8, WGM = 8;
__host__ __device__ __forceinline__ int lds_byte(int r, int c) { const int st = (r >> 4) * 2 + (c >> 5), rr = r & 15, cc = c & 31, ob = rr * 64 + cc * 2; return st * 1024 + (ob ^ (((ob >> 9) & 1) << 5)); }
__host__ __device__ __forceinline__ void stage_rc(int b, int& R, int& C) { const int st = b / 1024, sb = b % 1024, swz = sb ^ (((sb >> 9) & 1) << 5); R = (st >> 1) * 16 + swz / 64; C = (st & 1) * 32 + (swz % 64) / 2; }
__host__ __device__ __forceinline__ int perm32(int rho) { const int n = rho >> 4, i = rho & 15; return 8 * (i >> 2) + 4 * n + (i & 3); }

struct Unit { int pm, pn; };
struct Gemm { const bf16_t* A; const bf16_t* Bt; int lda, ldb, M, N, K; };

struct StaticOrder {
    int nM, nN, nwg, G, c;
    __host__ __device__ void init(int M, int N, int G_, int c_) { nM = M / BM; nN = N / BM; nwg = nM * nN; G = G_; c = c_; }
    __host__ __device__ bool next(int i, Unit& u) const {
        const long L = (long)i * G + c; if (L >= nwg) return false;
        int wgid = (int)L; { const int q = nwg / NXCD, r = nwg % NXCD, xcd = wgid % NXCD, off = wgid / NXCD; wgid = (xcd < r ? xcd * (q + 1) : r * (q + 1) + (xcd - r) * q) + off; }
        const int nig = WGM * nN, gid = wgid / nig, fm = gid * WGM, gsz = (nM - fm) < WGM ? (nM - fm) : WGM;
        u.pm = fm + ((wgid % nig) % gsz); u.pn = (wgid % nig) / gsz; return true;
    }
};

__device__ __forceinline__ float rs_from_ss(const float* ss, int row, int fq) {
    const f32x4 v = *(const f32x4*)(ss + (size_t)row * 16 + 4 * fq);
    float s = (v[0] + v[1]) + (v[2] + v[3]); s += __shfl_xor(s, 16); s += __shfl_xor(s, 32);
    return rsqrtf(s * (1.f / 1024.f) + 1e-6f);
}
__device__ __forceinline__ u32x4 pack8(const f32x4& a, const f32x4& b) { u32x4 w; w.x = cvtpk(a[0], a[1]); w.y = cvtpk(a[2], a[3]); w.z = cvtpk(b[0], b[1]); w.w = cvtpk(b[2], b[3]); return w; }

struct EpiSwiglu {
    static constexpr bool PERM = true;
    const float* ss; bf16_t* hid;
    __device__ __forceinline__ void operator()(const f32x4 (&acc)[2][2][4][2], const Unit& u, int wr, int wc, int fr, int fq) const {
        const int row0 = u.pm * BM + wr * 64 + fr, col0 = u.pn * 128 + wc * 32 + 8 * fq;
#pragma unroll
        for (int ai = 0; ai < 2; ++ai)
#pragma unroll
            for (int m = 0; m < 4; ++m) {
                const int row = row0 + ai * HALF + m * 16; const float rs = rs_from_ss(ss, row, fq);
                f32x4 h[2];
#pragma unroll
                for (int n = 0; n < 2; ++n) { const f32x4 a = acc[ai][0][m][n] * rs, b = acc[ai][1][m][n] * rs;
#pragma unroll
                    for (int i = 0; i < 4; ++i) h[n][i] = a[i] * b[i] * fsigmoid(a[i]); }
                *(u32x4*)(hid + (size_t)row * F_ + col0) = pack8(h[0], h[1]);
            }
    }
};
struct EpiRes {
    static constexpr bool PERM = true;
    const float* resid; float* outf; bf16_t* outb; float* ssout; float coef;
    __device__ __forceinline__ void operator()(const f32x4 (&acc)[2][2][4][2], const Unit& u, int wr, int wc, int fr, int fq) const {
        const int row0 = u.pm * BM + wr * 64 + fr, col0 = u.pn * BM + wc * 32 + 8 * fq;
#pragma unroll
        for (int ai = 0; ai < 2; ++ai)
#pragma unroll
            for (int m = 0; m < 4; ++m) {
                const int row = row0 + ai * HALF + m * 16; float sq = 0.f;
#pragma unroll
                for (int bj = 0; bj < 2; ++bj) {
                    const size_t off = (size_t)row * D_ + col0 + bj * HALF;
                    const f32x4 r0 = *(const f32x4*)(resid + off), r1 = *(const f32x4*)(resid + off + 4);
                    const f32x4 v0 = r0 + acc[ai][bj][m][0] * coef, v1 = r1 + acc[ai][bj][m][1] * coef;
                    *(f32x4*)(outf + off) = v0; *(f32x4*)(outf + off + 4) = v1;
                    *(u32x4*)(outb + off) = pack8(v0, v1);
                    sq += (v0[0] * v0[0] + v0[1] * v0[1]) + (v0[2] * v0[2] + v0[3] * v0[3]) + (v1[0] * v1[0] + v1[1] * v1[1]) + (v1[2] * v1[2] + v1[3] * v1[3]);
                }
                sq += __shfl_xor(sq, 16); sq += __shfl_xor(sq, 32);
                if (fq == 0) ssout[(size_t)row * 16 + u.pn * 4 + wc] = sq;
            }
    }
};
struct EpiInproj {
    static constexpr bool PERM = true;
    const float* ss; bf16_t* Z;
    __device__ __forceinline__ void operator()(const f32x4 (&acc)[2][2][4][2], const Unit& u, int wr, int wc, int fr, int fq) const {
        const int row0 = u.pm * BM + wr * 64 + fr, col0 = u.pn * BM + wc * 32 + 8 * fq;
#pragma unroll
        for (int ai = 0; ai < 2; ++ai)
#pragma unroll
            for (int m = 0; m < 4; ++m) {
                const int row = row0 + ai * HALF + m * 16; const float rs = rs_from_ss(ss, row, fq);
#pragma unroll
                for (int bj = 0; bj < 2; ++bj) {
                    const int col = col0 + bj * HALF;
                    if (col < NIN) {
                        f32x4 v0 = acc[ai][bj][m][0] * rs, v1 = acc[ai][bj][m][1] * rs;
                        if ((col >= ZC_GATE && col < ZC_QM) || col >= ZC_GA) {
#pragma unroll
                            for (int i = 0; i < 4; ++i) { v0[i] = fsigmoid(v0[i]); v1[i] = fsigmoid(v1[i]); }
                        }
                        *(u32x4*)(Z + (size_t)row * ZP + col) = pack8(v0, v1);
                    }
                }
            }
    }
};
template <int PASS> struct EpiUpmix {
    static constexpr bool PERM = true;
    const bf16_t* Z; bf16_t* outb;
    __device__ __forceinline__ void operator()(const f32x4 (&acc)[2][2][4][2], const Unit& u, int wr, int wc, int fr, int fq) const {
        const int row0 = u.pm * BM + wr * 64 + fr, col0 = u.pn * BM + wc * 32 + 8 * fq;
#pragma unroll
        for (int ai = 0; ai < 2; ++ai)
#pragma unroll
            for (int m = 0; m < 4; ++m) {
                const int row = row0 + ai * HALF + m * 16;
#pragma unroll
                for (int bj = 0; bj < 2; ++bj) {
                    const int col = col0 + bj * HALF;
                    const u32x4 gw = *(const u32x4*)(Z + (size_t)row * ZP + (PASS ? ZC_GB : ZC_GA) + col);
                    f32x4 v0, v1;
                    v0[0] = bflo(gw.x) * acc[ai][bj][m][0][0]; v0[1] = bfhi(gw.x) * acc[ai][bj][m][0][1]; v0[2] = bflo(gw.y) * acc[ai][bj][m][0][2]; v0[3] = bfhi(gw.y) * acc[ai][bj][m][0][3];
                    v1[0] = bflo(gw.z) * acc[ai][bj][m][1][0]; v1[1] = bfhi(gw.z) * acc[ai][bj][m][1][1]; v1[2] = bflo(gw.w) * acc[ai][bj][m][1][2]; v1[3] = bfhi(gw.w) * acc[ai][bj][m][1][3];
                    bf16_t* o = outb + (size_t)row * D_ + col;
                    if (PASS) { const u32x4 t = *(const u32x4*)o;
                        v0[0] += bflo(t.x); v0[1] += bfhi(t.x); v0[2] += bflo(t.y); v0[3] += bfhi(t.y); v1[0] += bflo(t.z); v1[1] += bfhi(t.z); v1[2] += bflo(t.w); v1[3] += bfhi(t.w); }
                    *(u32x4*)o = pack8(v0, v1);
                }
            }
    }
};
struct EpiPe {
    static constexpr bool PERM = true;
    float* pe;
    __device__ __forceinline__ void operator()(const f32x4 (&acc)[2][2][4][2], const Unit& u, int wr, int wc, int fr, int fq) const {
        const int row0 = u.pm * BM + wr * 64 + fr, col0 = u.pn * BM + wc * 32 + 8 * fq;
#pragma unroll
        for (int ai = 0; ai < 2; ++ai)
#pragma unroll
            for (int m = 0; m < 4; ++m)
#pragma unroll
                for (int bj = 0; bj < 2; ++bj) { const size_t off = (size_t)(row0 + ai * HALF + m * 16) * D_ + col0 + bj * HALF;
                    *(f32x4*)(pe + off) = acc[ai][bj][m][0]; *(f32x4*)(pe + off + 4) = acc[ai][bj][m][1]; }
    }
};
struct EpiPle {
    static constexpr bool PERM = true;
    const float* ss; const float* pe; float* h; float* ssout;
    __device__ __forceinline__ void operator()(const f32x4 (&acc)[2][2][4][2], const Unit& u, int wr, int wc, int fr, int fq) const {
        const int row0 = u.pm * BM + wr * 64 + fr, col0 = u.pn * BM + wc * 32 + 8 * fq;
#pragma unroll
        for (int ai = 0; ai < 2; ++ai)
#pragma unroll
            for (int m = 0; m < 4; ++m) {
                const int row = row0 + ai * HALF + m * 16; const float rs = rs_from_ss(ss, row, fq); float sq = 0.f;
#pragma unroll
                for (int bj = 0; bj < 2; ++bj) {
                    const size_t off = (size_t)row * D_ + col0 + bj * HALF;
#pragma unroll
                    for (int n = 0; n < 2; ++n) {
                        const f32x4 r = *(const f32x4*)(h + off + 4 * n), p = *(const f32x4*)(pe + off + 4 * n); f32x4 v;
#pragma unroll
                        for (int i = 0; i < 4; ++i) { v[i] = r[i] + fsigmoid(acc[ai][bj][m][n][i] * rs) * p[i]; sq += v[i] * v[i]; }
                        *(f32x4*)(h + off + 4 * n) = v;
                    }
                }
                sq += __shfl_xor(sq, 16); sq += __shfl_xor(sq, 32);
                if (fq == 0) ssout[(size_t)row * 16 + u.pn * 4 + wc] = sq;
            }
    }
};

template <class Epi, class Sched, bool ALIGN_EPI>
__device__ __forceinline__ void gemm_phase(LAS unsigned char* lds, const Gemm g, const Sched& S, const Epi& E) {
    const int tid = threadIdx.x, wid = __builtin_amdgcn_readfirstlane(tid >> 6), lane = tid & 63, wr = wid >> 2, wc = wid & 3, fr = lane & 15, fq = lane >> 4;
    const int K = g.K, nt = K / BK;
    unsigned voffA[2], voffB[2];
#pragma unroll
    for (int i = 0; i < 2; ++i) { int R, C; stage_rc(tid * 16 + i * 8192, R, C); const int Rb = Epi::PERM ? ((R & ~31) + perm32(R & 31)) : R;
        voffA[i] = (unsigned)(R * g.lda + C) * 2u; voffB[i] = (unsigned)(Rb * g.ldb + C) * 2u; }
    const size_t kstep = (size_t)(BK * 2);
    const size_t hstepA = (size_t)HALF * g.lda * 2, hstepB = (size_t)HALF * g.ldb * 2;
    const size_t tstepA = 2 * hstepA, tstepB = 2 * hstepB;
    const unsigned ldsw = (unsigned)wid * 1024u;
    const int aoff = lds_byte(wr * 64 + fr, fq * 8), boff = lds_byte(wc * 32 + fr, fq * 8);
#define PG8_SA(b, h) (((b) * 2 + (h)) * HTB)
#define PG8_SB(b, h) ((4 + (b) * 2 + (h)) * HTB)
#define PG8_STAGE(bufoff, gbase, voff) do { _Pragma("unroll") for (int _i = 0; _i < 2; ++_i) \
        __builtin_amdgcn_global_load_lds((const unsigned*)((const char*)(gbase) + (voff)[_i]), (LAS unsigned*)(lds + (bufoff) + ldsw + _i * 8192), 16, 0, 0); } while (0)
#define PG8_LDA(dst, b, h) do { _Pragma("unroll") for (int m = 0; m < 4; ++m) _Pragma("unroll") for (int k = 0; k < 2; ++k) dst[m][k] = *(const LAS bf16x8*)(lds + PG8_SA(b, h) + aoff + m * 2048 + k * 1024); } while (0)
#define PG8_LDB(dst, b, h) do { _Pragma("unroll") for (int n = 0; n < 2; ++n) _Pragma("unroll") for (int k = 0; k < 2; ++k) dst[n][k] = *(const LAS bf16x8*)(lds + PG8_SB(b, h) + boff + n * 2048 + k * 1024); } while (0)
#define PG8_MMA(ai, bj, At, Bt) do { __builtin_amdgcn_s_setprio(1); _Pragma("unroll") for (int m = 0; m < 4; ++m) _Pragma("unroll") for (int n = 0; n < 2; ++n) _Pragma("unroll") for (int k = 0; k < 2; ++k) \
        acc[ai][bj][m][n] = __builtin_amdgcn_mfma_f32_16x16x32_bf16(Bt[n][k], At[m][k], acc[ai][bj][m][n], 0, 0, 0); __builtin_amdgcn_s_setprio(0); } while (0)
#define PG8_WAIT_V(n) asm volatile("s_waitcnt vmcnt(" #n ")" ::: "memory")
#define PG8_WAIT_L(n) asm volatile("s_waitcnt lgkmcnt(" #n ")" ::: "memory")
#define PG8_BAR __builtin_amdgcn_s_barrier()
#define PG8_SCHED __builtin_amdgcn_sched_barrier(0)
    Unit cur, nxt; int ui = 0;
    if (!S.next(0, cur)) return;
    f32x4 acc[2][2][4][2];
#pragma unroll
    for (int a = 0; a < 2; ++a)
#pragma unroll
        for (int b = 0; b < 2; ++b)
#pragma unroll
            for (int m = 0; m < 4; ++m)
#pragma unroll
                for (int n = 0; n < 2; ++n) acc[a][b][m][n] = (f32x4){0.f, 0.f, 0.f, 0.f};
    bf16x8 At[4][2], B0[2][2], B1[2][2];
    const char* cA = (const char*)g.A + (size_t)cur.pm * tstepA; const char* cB = (const char*)g.Bt + (size_t)cur.pn * tstepB;
    PG8_STAGE(PG8_SB(0, 0), cB, voffB); PG8_STAGE(PG8_SB(0, 1), cB + hstepB, voffB); PG8_STAGE(PG8_SA(0, 0), cA, voffA); PG8_STAGE(PG8_SA(0, 1), cA + hstepA, voffA);
    if (wr == 1) PG8_BAR;
    PG8_WAIT_V(2); PG8_BAR;
    PG8_STAGE(PG8_SB(1, 0), cB + kstep, voffB); PG8_STAGE(PG8_SA(1, 0), cA + kstep, voffA); PG8_STAGE(PG8_SB(1, 1), cB + hstepB + kstep, voffB);
    PG8_WAIT_V(6); PG8_BAR;
    for (;;) {
        const bool has_next = S.next(ui + 1, nxt);
        const char* nA = has_next ? (const char*)g.A + (size_t)nxt.pm * tstepA : cA; const char* nB = has_next ? (const char*)g.Bt + (size_t)nxt.pn * tstepB : cB;
        for (int t = 0; t < nt; t += 2) {
            const bool last = (t == nt - 2);
            const char* a1 = cA + (size_t)(t + 1) * kstep;
            const char* a2 = last ? nA : cA + (size_t)(t + 2) * kstep; const char* b2 = last ? nB : cB + (size_t)(t + 2) * kstep;
            const char* a3 = a2 + kstep; const char* b3 = b2 + kstep;
            PG8_LDB(B0, 0, 0); PG8_LDB(B1, 0, 1); PG8_SCHED; PG8_LDA(At, 0, 0); PG8_STAGE(PG8_SA(1, 1), a1 + hstepA, voffA);
            PG8_WAIT_V(8); PG8_WAIT_L(0); PG8_BAR; PG8_MMA(0, 0, At, B0); PG8_MMA(0, 1, At, B1); PG8_BAR; PG8_SCHED;
            PG8_LDA(At, 0, 1); PG8_STAGE(PG8_SB(0, 0), b2, voffB); PG8_STAGE(PG8_SB(0, 1), b2 + hstepB, voffB); PG8_STAGE(PG8_SA(0, 0), a2, voffA);
            PG8_WAIT_V(8); PG8_WAIT_L(0); PG8_BAR; PG8_MMA(1, 0, At, B0); PG8_MMA(1, 1, At, B1); PG8_BAR; PG8_SCHED;
            PG8_LDB(B0, 1, 0); PG8_LDB(B1, 1, 1); PG8_SCHED; PG8_LDA(At, 1, 0); PG8_STAGE(PG8_SA(0, 1), a2 + hstepA, voffA);
            PG8_WAIT_V(8); PG8_WAIT_L(0); PG8_BAR; PG8_MMA(0, 0, At, B0); PG8_MMA(0, 1, At, B1); PG8_BAR; PG8_SCHED;
            PG8_LDA(At, 1, 1); PG8_STAGE(PG8_SB(1, 0), b3, voffB); PG8_STAGE(PG8_SB(1, 1), b3 + hstepB, voffB); PG8_STAGE(PG8_SA(1, 0), a3, voffA);
            PG8_WAIT_V(8); PG8_WAIT_L(0); PG8_BAR; PG8_MMA(1, 0, At, B0); PG8_MMA(1, 1, At, B1); PG8_BAR; PG8_SCHED;
        }
        if constexpr (ALIGN_EPI) { if (wr == 0) PG8_BAR; }
        E(acc, cur, wr, wc, fr, fq);
        if (!has_next) break;
#pragma unroll
        for (int a = 0; a < 2; ++a)
#pragma unroll
            for (int b = 0; b < 2; ++b)
#pragma unroll
                for (int m = 0; m < 4; ++m)
#pragma unroll
                    for (int n = 0; n < 2; ++n) acc[a][b][m][n] = (f32x4){0.f, 0.f, 0.f, 0.f};
        cur = nxt; cA = nA; cB = nB; ++ui;
        if constexpr (ALIGN_EPI) { if (wr == 1) PG8_BAR; }
    }
    PG8_WAIT_V(0);
    if constexpr (!ALIGN_EPI) { if (wr == 0) PG8_BAR; }
    PG8_BAR;
#undef PG8_SA
#undef PG8_SB
#undef PG8_STAGE
#undef PG8_LDA
#undef PG8_LDB
#undef PG8_MMA
#undef PG8_WAIT_V
#undef PG8_WAIT_L
#undef PG8_BAR
#undef PG8_SCHED
}
}
typedef GAS unsigned gu32;
#define RLX_AGENT __ATOMIC_RELAXED, __HIP_MEMORY_SCOPE_AGENT
#define LDS_WAIT() asm volatile("s_waitcnt lgkmcnt(0)" ::: "memory")
#define VM_WAIT() asm volatile("s_waitcnt vmcnt(0)" ::: "memory")
#define XB_TMO      128
#define XB_XCNT(j)  (256  + 64 * (j))
#define XB_XSUB(j)  (1280 + 64 * (j))
#define XB_XGEN(j)  (2304 + 64 * (j))
#define XB_TOP      3328
#define XB_TOPGEN   3392
#define XCD_BAR_WORDS 3456
#define XB_SPIN_CAP (1u << 20)
constexpr int CW_BAR = 1024;
constexpr int CW_QUEUE = 8192;
static_assert((CW_BAR + XCD_BAR_WORDS) * 4 <= (int)CTL_ZERO_BYTES && (CW_QUEUE + 64 * 8) * 4 <= (int)CTL_ZERO_BYTES, "ctl words inside the memset region");

__device__ __forceinline__ unsigned xb_ld(unsigned* p)              { return __hip_atomic_load(p, __ATOMIC_RELAXED, __HIP_MEMORY_SCOPE_AGENT); }
__device__ __forceinline__ unsigned xb_add(unsigned* p, unsigned v) { return __hip_atomic_fetch_add(p, v, __ATOMIC_RELAXED, __HIP_MEMORY_SCOPE_AGENT); }
__device__ __forceinline__ unsigned xb_xcc_id() { return (unsigned)__builtin_amdgcn_s_getreg((3 << 11) | 20) & 0xFu; }
#define XB_SPIN(cond, bar) do { unsigned _sp = 0; while (cond) { __builtin_amdgcn_s_sleep(1); \
    if ((++_sp & 255u) == 0u) { if (xb_ld(&(bar)[XB_TMO])) break; if (_sp > XB_SPIN_CAP) { atomicAdd(&(bar)[XB_TMO], 1u); break; } } } } while (0)

struct XcdBarrier { unsigned* bar; unsigned x; volatile LAS unsigned* st; };
__device__ __forceinline__ XcdBarrier xcd_barrier_post(unsigned* bar, volatile LAS unsigned* st) {
    XcdBarrier b; b.bar = bar; b.x = xb_xcc_id(); b.st = st;
    if (threadIdx.x == 0) (void)xb_add(&bar[XB_XCNT(b.x)], 1u);
    return b;
}
__device__ __forceinline__ void xcd_barrier_complete(unsigned* bar, unsigned x, unsigned& nloc, unsigned& nx) {
    const unsigned G = gridDim.x * gridDim.y * gridDim.z;
    unsigned sum, cnt, mine, sp = 0u;
    for (;;) {
        sum = 0u; cnt = 0u; mine = 0u;
#pragma unroll
        for (unsigned j = 0; j < 16; ++j) { const unsigned c = xb_ld(&bar[XB_XCNT(j)]); sum += c; cnt += (c > 0u) ? 1u : 0u; mine = (j == x) ? c : mine; }
        if (sum == G) break;
        __builtin_amdgcn_s_sleep(1);
        if ((++sp & 255u) == 0u) { if (xb_ld(&bar[XB_TMO])) break; if (sp > XB_SPIN_CAP) { atomicAdd(&bar[XB_TMO], 1u); break; } }
    }
    nloc = mine > 0u ? mine : 1u; nx = cnt > 0u ? cnt : 1u;
}
__device__ __forceinline__ void xcd_barrier(const XcdBarrier& b) {
    asm volatile("s_waitcnt vmcnt(0)" ::: "memory");
    __syncthreads();
    if (threadIdx.x == 0) {
        unsigned* bar = b.bar;
        __builtin_amdgcn_s_waitcnt(0);
        unsigned nloc = b.st[0], nx = b.st[1];
        if (nloc == 0u) { xcd_barrier_complete(bar, b.x, nloc, nx); b.st[0] = nloc; b.st[1] = nx; }
        const unsigned old = xb_add(&bar[XB_XSUB(b.x)], 1u);
        const unsigned gen = old / nloc;
        if (old + 1u == (gen + 1u) * nloc) {
            __builtin_amdgcn_fence(__ATOMIC_RELEASE, "agent");
            asm volatile("s_waitcnt vmcnt(0)" ::: "memory");
            const unsigned og = xb_add(&bar[XB_TOP], 1u);
            const unsigned tg = og / nx;
            if (og + 1u == (tg + 1u) * nx) xb_add(&bar[XB_TOPGEN], 1u);
            else XB_SPIN(xb_ld(&bar[XB_TOPGEN]) == tg, bar);
            __builtin_amdgcn_fence(__ATOMIC_ACQUIRE, "agent");
            xb_add(&bar[XB_XGEN(b.x)], 1u);
            asm volatile("s_waitcnt vmcnt(0)" ::: "memory");
        } else {
            XB_SPIN(xb_ld(&bar[XB_XGEN(b.x)]) == gen, bar);
            __builtin_amdgcn_fence(__ATOMIC_ACQUIRE, "agent");
            asm volatile("s_waitcnt vmcnt(0)" ::: "memory");
        }
    }
    __syncthreads();
}

struct Args { const float* in[25]; float* out; unsigned char* ws; int ph_lo, ph_hi; };
static_assert(sizeof(Args) == 25 * 8 + 8 + 8 + 8, "no padding");

__device__ __forceinline__ void tr_item(const float* W, const float* gain, bf16_t* Wt, int K, int N, int mode, int roff, bool qscale, LAS float* scr, int item, int lane) {
    const int nblk = (N + 31) >> 5, kb = item / nblk, nb = item - kb * nblk, k0 = 64 * kb, n0 = 32 * nb;
#pragma unroll 8
    for (int i = 0; i < 32; ++i) {
        const int kk = 2 * i + (lane >> 5), n = n0 + (lane & 31);
        float v = 0.f;
        if (n < N) { v = W[(size_t)(k0 + kk) * N + n]; if (gain) v *= gain[k0 + kk]; }
        scr[kk * 33 + (lane & 31)] = v;
    }
    LDS_WAIT(); asm volatile("" ::: "memory");
    const int c = lane & 7;
#pragma unroll
    for (int j = 0; j < 4; ++j) {
        const int nl = (lane >> 3) + 8 * j, n = n0 + nl;
        if (n < N) {
            const LAS float* s = scr + (8 * c) * 33 + nl;
            const float sc = (qscale && ((n >= ZC_QN && n < ZC_QN + 512) || (n >= ZC_QM && n < ZC_QM + 512))) ? C2 : 1.f;
            u32x4 o;
            o.x = pk2(s[0 * 33] * sc, s[1 * 33] * sc); o.y = pk2(s[2 * 33] * sc, s[3 * 33] * sc);
            o.z = pk2(s[4 * 33] * sc, s[5 * 33] * sc); o.w = pk2(s[6 * 33] * sc, s[7 * 33] * sc);
            const int drow = mode ? ((n >> 7) * 256 + (n & 127) + roff) : n;
            *(u32x4*)(Wt + (size_t)drow * K + k0 + 8 * c) = o;
        }
    }
    LDS_WAIT(); asm volatile("" ::: "memory");
}
constexpr int trcnt(int K, int N) { return (K / 64) * ((N + 31) / 32); }
constexpr int I_W13 = trcnt(D_, F_), I_W2 = trcnt(F_, D_), I_WIN = trcnt(D_, NIN), I_WUP = trcnt(512, D_), I_WDD = trcnt(D_, D_), I_WPLE = trcnt(PLE_, D_), I_WC1 = trcnt(2048, 128);
constexpr int TR_NITEMS = 4 * I_W13 + 2 * I_W2 + I_WIN + 2 * I_WUP + 2 * I_WDD + I_WPLE + 2 * I_WC1;

__device__ __forceinline__ void p0_prologue(const Args& a, LAS unsigned char* lds, int vcu, int G, int wave, int lane, int tid) {
    unsigned char* ws = a.ws;
    LAS float* scr = (LAS float*)(lds + wave * 16384);
    const int gw = vcu * NWAVES + wave, NGW = G * NWAVES;
    for (int it = gw; it < TR_NITEMS; it += NGW) {
        int r = it;
        if (r < I_W13) { tr_item(a.in[3], a.in[2], (bf16_t*)(ws + WS_W13A), D_, F_, 1, 0, false, scr, r, lane); continue; } r -= I_W13;
        if (r < I_W13) { tr_item(a.in[4], a.in[2], (bf16_t*)(ws + WS_W13A), D_, F_, 1, 128, false, scr, r, lane); continue; } r -= I_W13;
        if (r < I_W2) { tr_item(a.in[5], nullptr, (bf16_t*)(ws + WS_W2A), F_, D_, 0, 0, false, scr, r, lane); continue; } r -= I_W2;
        if (r < I_W13) { tr_item(a.in[18], a.in[17], (bf16_t*)(ws + WS_W13B), D_, F_, 1, 0, false, scr, r, lane); continue; } r -= I_W13;
        if (r < I_W13) { tr_item(a.in[19], a.in[17], (bf16_t*)(ws + WS_W13B), D_, F_, 1, 128, false, scr, r, lane); continue; } r -= I_W13;
        if (r < I_W2) { tr_item(a.in[20], nullptr, (bf16_t*)(ws + WS_W2B), F_, D_, 0, 0, false, scr, r, lane); continue; } r -= I_W2;
        if (r < I_WIN) { tr_item(a.in[7], a.in[6], (bf16_t*)(ws + WS_WIN), D_, NIN, 0, 0, true, scr, r, lane); continue; } r -= I_WIN;
        if (r < I_WUP) { tr_item(a.in[14], nullptr, (bf16_t*)(ws + WS_WUPN), 512, D_, 0, 0, false, scr, r, lane); continue; } r -= I_WUP;
        if (r < I_WUP) { tr_item(a.in[15], nullptr, (bf16_t*)(ws + WS_WUPM), 512, D_, 0, 0, false, scr, r, lane); continue; } r -= I_WUP;
        if (r < I_WDD) { tr_item(a.in[16], nullptr, (bf16_t*)(ws + WS_WOUT), D_, D_, 0, 0, false, scr, r, lane); continue; } r -= I_WDD;
        if (r < I_WDD) { tr_item(a.in[22], a.in[21], (bf16_t*)(ws + WS_WPG), D_, D_, 0, 0, false, scr, r, lane); continue; } r -= I_WDD;
        if (r < I_WPLE) { tr_item(a.in[23], nullptr, (bf16_t*)(ws + WS_WPLE), PLE_, D_, 0, 0, false, scr, r, lane); continue; } r -= I_WPLE;
        if (r < I_WC1) { tr_item(a.in[9], nullptr, (bf16_t*)(ws + WS_WC1K), 2048, 128, 0, 0, false, scr, r, lane); continue; } r -= I_WC1;
        tr_item(a.in[12], nullptr, (bf16_t*)(ws + WS_WC1V), 2048, 128, 0, 0, false, scr, r, lane);
    }
    { const float* x = a.in[0]; bf16_t* xb = (bf16_t*)(ws + WS_AB); float* ss = (float*)(ws + WS_SS);
      for (int row = gw; row < M_; row += NGW) {
          const f32x4* xr = (const f32x4*)(x + (size_t)row * D_) + lane; u32x2* o = (u32x2*)(xb + (size_t)row * D_) + lane; float s = 0.f;
#pragma unroll
          for (int j = 0; j < 4; ++j) { const f32x4 v = xr[64 * j]; s += (v[0] * v[0] + v[1] * v[1]) + (v[2] * v[2] + v[3] * v[3]); u32x2 w; w.x = cvtpk(v[0], v[1]); w.y = cvtpk(v[2], v[3]); o[64 * j] = w; }
          s = wsum(s);
          if (lane < 16) ss[(size_t)row * 16 + lane] = lane == 0 ? s : 0.f;
      } }
    { const f32x4* p = (const f32x4*)a.in[1]; u32x4* pb = (u32x4*)(ws + WS_PB); const int gt = vcu * NTHR + tid, NGT = G * NTHR;
      for (int i = gt; i < M_ * PLE_ / 8; i += NGT) { const f32x4 u = p[2 * i], v = p[2 * i + 1]; u32x4 o; o.x = cvtpk(u[0], u[1]); o.y = cvtpk(u[2], u[3]); o.z = cvtpk(v[0], v[1]); o.w = cvtpk(v[2], v[3]); pb[i] = o; }
      u32x4* wz = (u32x4*)(ws + WS_WIN + (size_t)NIN * D_ * 2);
      for (int i = gt; i < (NINP - NIN) * D_ * 2 / 16; i += NGT) wz[i] = (u32x4){0u, 0u, 0u, 0u}; }
    if (gw < 256) { const int kv = gw >> 7, j = gw & 127; const float* pos = a.in[kv ? 11 : 8]; const float* w1 = a.in[kv ? 12 : 9]; float s = 0.f;
        for (int i = lane; i < 2048; i += 64) s += pos[i] * w1[(size_t)i * 128 + j];
        s = wsum(s); if (lane == 0) ((float*)(ws + WS_CBIAS))[gw] = s; }
}

__device__ __forceinline__ float gelu_tanh(float x) { const float u = 0.7978845608028654f * (x + 0.044715f * x * x * x); return 0.5f * x * (1.f + tanhf(u)); }
__device__ __forceinline__ float dot64(const LAS float* q, const bf16_t* row) {
    const u32x4* r = (const u32x4*)row; float s = 0.f;
#pragma unroll
    for (int i = 0; i < 8; ++i) { const u32x4 v = r[i]; const LAS float* qq = q + 8 * i;
        s += qq[0] * bflo(v.x) + qq[1] * bfhi(v.x) + qq[2] * bflo(v.y) + qq[3] * bfhi(v.y) + qq[4] * bflo(v.z) + qq[5] * bfhi(v.z) + qq[6] * bflo(v.w) + qq[7] * bfhi(v.w); }
    return s;
}
__device__ __forceinline__ void chunk_step(const LAS float* q, const bf16_t* kbase, const bf16_t* vbase, int kpos0, int t, int kmin, float slope2, int lane, float& m, float& l, float& o) {
    const int kpos = kpos0 + lane; const bool ok = kpos <= t && kpos >= kmin;
    float s = -1e30f;
    if (ok) s = dot64(q, kbase + (size_t)lane * ZP) - slope2 * (float)(t - kpos);
    const float mn = fmaxf(m, wmax(s)); const float alpha = exp2f(m - mn); const float p = ok ? exp2f(s - mn) : 0.f;
    l = l * alpha + wsum(p); o *= alpha; m = mn;
    for (int key = 0; key < 64; ++key) { const float pk = __shfl(p, key); if (pk != 0.f) o += pk * bf2f(vbase[(size_t)key * ZP + lane]); }
}
__device__ __forceinline__ void cmp_phase_simple(const Args& a, LAS unsigned char* lds, int vcu, int G, int tid) {
    unsigned char* ws = a.ws; const bf16_t* Z = (const bf16_t*)(ws + WS_R);
    const int sub = tid >> 7, st = tid & 127;
    LAS float* xin = (LAS float*)lds + sub * 2048; LAS float* hid = (LAS float*)(lds + 32768) + sub * 128;
    for (int it0 = vcu * 4; it0 < 4096; it0 += G * 4) {
        const int it = it0 + sub, kv = it >> 11, bg = (it >> 7) & 15, c = it & 127, b = bg >> 1, g = bg & 1;
        bf16_t* outc = (bf16_t*)(ws + (kv ? WS_VC : WS_KC)) + ((size_t)bg * 128 + c) * 64;
        const int coloff = (kv ? ZC_VCMP : ZC_KCMP) + g * 64;
        if (c < 127) for (int i = st; i < 2048; i += 128) { const int l = i >> 6, d = i & 63; xin[i] = bf2f(Z[((size_t)b * S_ + 16 * c + l) * ZP + coloff + d]); }
        __syncthreads();
        if (c < 127) {
            const bf16_t* w1 = (const bf16_t*)(ws + (kv ? WS_WC1V : WS_WC1K)) + (size_t)st * 2048;
            float acc = ((const float*)(ws + WS_CBIAS))[kv * 128 + st];
            for (int i = 0; i < 2048; i += 8) { const u32x4 w = *(const u32x4*)(w1 + i);
                acc += xin[i] * bflo(w.x) + xin[i + 1] * bfhi(w.x) + xin[i + 2] * bflo(w.y) + xin[i + 3] * bfhi(w.y) + xin[i + 4] * bflo(w.z) + xin[i + 5] * bfhi(w.z) + xin[i + 6] * bflo(w.w) + xin[i + 7] * bfhi(w.w); }
            hid[st] = gelu_tanh(acc);
        }
        __syncthreads();
        if (st < 64) { float s = 0.f; if (c < 127) { const float* w2 = a.in[kv ? 13 : 10]; for (int j = 0; j < 128; ++j) s += hid[j] * w2[j * 64 + st]; } outc[st] = (bf16_t)f2bf(s); }
        __syncthreads();
    }
}
__device__ __forceinline__ void kmean_phase_simple(const Args& a, int vcu, int G, int wave, int lane) {
    const bf16_t* Z = (const bf16_t*)(a.ws + WS_R); float* kmean = (float*)(a.ws + WS_KMEAN);
    for (int it = vcu * NWAVES + wave; it < 512; it += G * NWAVES) {
        const int n = it & 7, h = (it >> 3) & 7, b = it >> 6; float s = 0.f;
        for (int i = 0; i < 256; ++i) s += bf2f(Z[((size_t)b * S_ + 256 * n + i) * ZP + ZC_KM + h * 64 + lane]);
        kmean[(size_t)it * 64 + lane] = s * (1.f / 256.f);
    }
}
__device__ __forceinline__ void nsa_item_simple(bf16_t* Z, const bf16_t* kc, const bf16_t* vc, int b, int t, LAS float* L, int tid) {
    const int lane = tid & 63, h = tid >> 6, g = h >> 2, bg = b * 2 + g;
    LAS float* q_s = L; LAS float* p_s = L + 512; LAS float* imp_s = L + 1536; LAS unsigned* mask_s = (LAS unsigned*)(L + 1600);
    bf16_t* zrow = Z + ((size_t)b * S_ + t) * ZP;
    q_s[h * 64 + lane] = bf2f(zrow[ZC_QN + h * 64 + lane]);
    const float slope2 = exp2f(-(float)(2 * h + 1) * 0.5f) * LOG2E;
    __syncthreads();
    const LAS float* q = q_s + h * 64;
    const int ncv = t >= 31 ? ((t - 31) >> 4) + 1 : 0;
    const bool ok0 = lane < ncv, ok1 = lane + 64 < ncv;
    float s0 = -1e30f, s1 = -1e30f;
    if (ok0) s0 = dot64(q, kc + ((size_t)bg * 128 + lane) * 64) - slope2 * (float)(t - (16 * lane + 31));
    if (ok1) s1 = dot64(q, kc + ((size_t)bg * 128 + lane + 64) * 64) - slope2 * (float)(t - (16 * (lane + 64) + 31));
    const float mc = wmax(fmaxf(s0, s1));
    const float e0 = ok0 ? exp2f(s0 - mc) : 0.f, e1 = ok1 ? exp2f(s1 - mc) : 0.f;
    const float lc = wsum(e0 + e1), inv = 1.f / fmaxf(lc, 1e-30f);
    p_s[h * 128 + lane] = e0 * inv; p_s[h * 128 + lane + 64] = e1 * inv;
    __syncthreads();
    if (tid < 64) {
        const int gg = tid >> 5, j = tid & 31, lo = max(0, 4 * j - 1), hi = min(126, 4 * j + 3); float s = 0.f;
        for (int hh = 0; hh < 4; ++hh) for (int c = lo; c <= hi; ++c) s += p_s[(gg * 4 + hh) * 128 + c];
        imp_s[gg * 32 + j] = s;
    }
    __syncthreads();
    const int cur = t >> 6;
    if (tid < 64) {
        const int gg = lane >> 5, j = lane & 31;
        const bool causal = j <= cur, forced = (j == 0) || (j == cur) || (j == cur - 1);
        const float val = !causal ? -1e30f : (forced ? 1e9f : imp_s[gg * 32 + j]);
        int rank = 0;
        for (int jj = 0; jj < 32; ++jj) {
            const bool cj = jj <= cur, fj = (jj == 0) || (jj == cur) || (jj == cur - 1);
            const float vv = !cj ? -1e30f : (fj ? 1e9f : imp_s[gg * 32 + jj]);
            rank += (vv > val || (vv == val && jj < j)) ? 1 : 0;
        }
        const unsigned long long bal = __ballot(rank < 16 && causal);
        if (lane == 0) { mask_s[0] = (unsigned)bal; mask_s[1] = (unsigned)(bal >> 32); }
    }
    __syncthreads();
    const unsigned mask = mask_s[g];
    float oc = 0.f;
    for (int c = 0; c < ncv; ++c) oc += p_s[h * 128 + c] * bf2f(vc[((size_t)bg * 128 + c) * 64 + lane]);
    const bf16_t* zb = Z + (size_t)b * S_ * ZP;
    float ms = -1e30f, ls = 0.f, os = 0.f;
    for (int j = 0; j <= cur; ++j) {
        if (!((mask >> j) & 1u)) continue;
        chunk_step(q, zb + (size_t)(64 * j) * ZP + ZC_KSLC + g * 64, zb + (size_t)(64 * j) * ZP + ZC_VSLC + g * 64, 64 * j, t, 0, slope2, lane, ms, ls, os);
    }
    float mw = -1e30f, lw = 0.f, ow = 0.f;
    const int kmin = max(0, t - 511);
    for (int k0 = kmin & ~63; k0 <= t; k0 += 64)
        chunk_step(q, zb + (size_t)k0 * ZP + ZC_KWIN + g * 64, zb + (size_t)k0 * ZP + ZC_VWIN + g * 64, k0, t, kmin, slope2, lane, mw, lw, ow);
    const float g0 = bf2f(zrow[ZC_GATE + h * 3 + 0]), g1 = bf2f(zrow[ZC_GATE + h * 3 + 1]), g2 = bf2f(zrow[ZC_GATE + h * 3 + 2]);
    const float o = g0 * oc + g1 * (os / ls) + g2 * (ow / lw);
    zrow[ZC_QN + h * 64 + lane] = (bf16_t)f2bf(o);
    __syncthreads();
}
__device__ __forceinline__ void moba_item_simple(bf16_t* Z, const float* kmean, int b, int t, LAS float* L, int tid) {
    const int lane = tid & 63, h = tid >> 6;
    bf16_t* zrow = Z + ((size_t)b * S_ + t) * ZP;
    const float qv = bf2f(zrow[ZC_QM + h * 64 + lane]);
    L[h * 64 + lane] = qv;
    const float slope2 = exp2f(-(float)(h + 1)) * LOG2E;
    __syncthreads();
    const LAS float* q = L + h * 64;
    const int cur = t >> 8;
    float gs[8];
#pragma unroll
    for (int j = 0; j < 8; ++j) { gs[j] = -1e30f; if (j < cur) gs[j] = wsum(qv * kmean[(((size_t)b * 8 + h) * 8 + j) * 64 + lane]); }
    unsigned sel = 0;
#pragma unroll
    for (int j = 0; j < 8; ++j) {
        int rank = 0;
#pragma unroll
        for (int jj = 0; jj < 8; ++jj) rank += (gs[jj] > gs[j] || (gs[jj] == gs[j] && jj < j)) ? 1 : 0;
        if (j < cur && rank < 3) sel |= 1u << j;
    }
    const bf16_t* zb = Z + (size_t)b * S_ * ZP;
    float m = -1e30f, l = 0.f, o = 0.f;
    for (int j = 0; j < cur; ++j) {
        if (!((sel >> j) & 1u)) continue;
        for (int k0 = 256 * j; k0 < 256 * j + 256; k0 += 64)
            chunk_step(q, zb + (size_t)k0 * ZP + ZC_KM + h * 64, zb + (size_t)k0 * ZP + ZC_VM + h * 64, k0, t, 0, slope2, lane, m, l, o);
    }
    for (int k0 = 256 * cur; k0 <= t; k0 += 64)
        chunk_step(q, zb + (size_t)k0 * ZP + ZC_KM + h * 64, zb + (size_t)k0 * ZP + ZC_VM + h * 64, k0, t, 0, slope2, lane, m, l, o);
    zrow[ZC_QM + h * 64 + lane] = (bf16_t)f2bf(o / l);
    __syncthreads();
}
namespace fa {
constexpr int L_K = 0, L_V = 16384, L_IMPA = 32768  , L_IMPB = L_IMPA + 33792  , L_IMPS = L_IMPB + 33792  , L_SELM = L_IMPS + 8448  ,
              L_MISC = L_SELM + 256  , L_KMEAN = L_MISC + 64  , L_LINV = L_KMEAN + 2048  , L_END = L_LINV + 1024;
static_assert(L_END <= 131072, "attention LDS inside the ring region");
constexpr float THR = 12.f;

__device__ __forceinline__ int crow(int r, int hi) { return (r & 3) + 8 * (r >> 2) + 4 * hi; }
__device__ __forceinline__ float xmax(float v) { auto rr = __builtin_amdgcn_permlane32_swap(__float_as_uint(v), __float_as_uint(v), false, false); return fmaxf(__uint_as_float(rr[0]), __uint_as_float(rr[1])); }
__device__ __forceinline__ float xsum(float v) { auto rr = __builtin_amdgcn_permlane32_swap(__float_as_uint(v), __float_as_uint(v), false, false); return __uint_as_float(rr[0]) + __uint_as_float(rr[1]); }
typedef short v4i16_t __attribute__((ext_vector_type(4)));
typedef short s16x4 __attribute__((ext_vector_type(4)));
__device__ __forceinline__ s16x4 vtr(const LAS unsigned char* p) { return __builtin_bit_cast(s16x4, __builtin_amdgcn_ds_read_tr16_b64_v4i16((LAS v4i16_t*)p)); }

struct StageRegs { u32x4 k, v; };
__device__ __forceinline__ void stage_load(StageRegs& s, const bf16_t* Kb, const bf16_t* Vb, int pitch, int w, int lane) {
    s.k = *(const u32x4*)(Kb + (size_t)lane * pitch + w * 8);
    s.v = *(const u32x4*)(Vb + (size_t)(16 * (w & 3) + (lane >> 2)) * pitch + (w >> 2) * 32 + (lane & 3) * 8);
}
__device__ __forceinline__ void stage_write(const StageRegs& s, LAS unsigned char* L, int buf, int w, int lane) {
    *(LAS u32x4*)(L + L_K + buf * 8192 + w * 1024 + lane * 16) = s.k;
    *(LAS u32x4*)(L + L_V + buf * 8192 + w * 1024 + lane * 16) = s.v;
}
__device__ __forceinline__ f32x16 qk_block(const LAS unsigned char* kslot, int blk, const bf16x8 (&qr)[4], f32x16 c, int r32, int hi) {
    const LAS unsigned char* kb = kslot + hi * 1024 + r32 * 16 + blk * 512;
#pragma unroll
    for (int s = 0; s < 4; ++s) { const bf16x8 kf = *(const LAS bf16x8*)(kb + s * 2048); c = __builtin_amdgcn_mfma_f32_32x32x16_bf16(kf, qr[s], c, 0, 0, 0); }
    return c;
}
__device__ __forceinline__ void pv_step(const LAS unsigned char* vslot, int ks, bf16x8 pf, f32x16& o0, f32x16& o1, int lane) {
    const int hi = lane >> 5;
    const LAS unsigned char* vb = vslot + ((lane >> 4) & 1) * 32 + (lane & 3) * 8 + (4 * hi + ((lane & 15) >> 2)) * 64 + ks * 1024;
    const s16x4 a0 = vtr(vb), a1 = vtr(vb + 512), b0 = vtr(vb + 4096), b1 = vtr(vb + 4096 + 512);
    const bf16x8 v0 = (bf16x8){a0[0], a0[1], a0[2], a0[3], a1[0], a1[1], a1[2], a1[3]}, v1 = (bf16x8){b0[0], b0[1], b0[2], b0[3], b1[0], b1[1], b1[2], b1[3]};
    o0 = __builtin_amdgcn_mfma_f32_32x32x16_bf16(v0, pf, o0, 0, 0, 0);
    o1 = __builtin_amdgcn_mfma_f32_32x32x16_bf16(v1, pf, o1, 0, 0, 0);
}
__device__ __forceinline__ bf16x8 pack_p(const f32x16& p, int base) {
    u32x4 w; w.x = cvtpk(p[base], p[base + 1]); w.y = cvtpk(p[base + 2], p[base + 3]); w.z = cvtpk(p[base + 4], p[base + 5]); w.w = cvtpk(p[base + 6], p[base + 7]);
    return __builtin_bit_cast(bf16x8, w);
}
struct State { float dl, l; f32x16 o0, o1; };
__device__ __forceinline__ void tile_compute(const LAS unsigned char* kslot, const LAS unsigned char* vslot, const bf16x8 (&qr)[4], float slope2, float off0, int mode, int qq, State& st, int lane) {
    const int r32 = lane & 31, hi = lane >> 5;
    f32x16 p0, p1;
    { const float oh0 = off0 + slope2 * (float)(4 * hi), oh1 = oh0 + slope2 * 32.f;
#pragma unroll
      for (int r = 0; r < 16; ++r) { const float cr = (float)((r & 3) + 8 * (r >> 2)); p0[r] = slope2 * cr + oh0; p1[r] = slope2 * cr + oh1; } }
    p0 = qk_block(kslot, 0, qr, p0, r32, hi);
    p1 = qk_block(kslot, 1, qr, p1, r32, hi);
    if (mode) {
        const bool causal = (mode == 1);
#pragma unroll
        for (int r = 0; r < 16; ++r) { const int d0 = crow(r, hi) - qq; if ((d0 <= 0) != causal) p0[r] = -INFINITY; if ((d0 + 32 <= 0) != causal) p1[r] = -INFINITY; }
    }
    float rm = fmaxf(p0[0], p1[0]);
#pragma unroll
    for (int r = 1; r < 16; ++r) rm = fmaxf(rm, fmaxf(p0[r], p1[r]));
    rm = xmax(rm);
    if (__any(rm > THR)) {
        const float d = fmaxf(rm, 0.f), f = __builtin_amdgcn_exp2f(-d);
        st.dl += d; st.l *= f;
#pragma unroll
        for (int r = 0; r < 16; ++r) { p0[r] -= d; p1[r] -= d; st.o0[r] *= f; st.o1[r] *= f; }
    }
    float sm = 0.f;
#pragma unroll
    for (int r = 0; r < 16; ++r) { p0[r] = __builtin_amdgcn_exp2f(p0[r]); p1[r] = __builtin_amdgcn_exp2f(p1[r]); sm += p0[r] + p1[r]; }
    st.l += sm;
    pv_step(vslot, 0, pack_p(p0, 0), st.o0, st.o1, lane);
    pv_step(vslot, 1, pack_p(p0, 8), st.o0, st.o1, lane);
    pv_step(vslot, 2, pack_p(p1, 0), st.o0, st.o1, lane);
    pv_step(vslot, 3, pack_p(p1, 8), st.o0, st.o1, lane);
}
__device__ __forceinline__ void tile_loop(unsigned tm, unsigned lsel, int jdiag, int jfar, const bf16_t* zb, int kcol, int vcol, const bf16x8 (&qr)[4], float slope2, int tq, int qq,
                                          State& st, LAS unsigned char* L, int& buf, int w, int lane) {
    StageRegs sr;
    if (tm) { const int j = 31 - __builtin_clz(tm); stage_load(sr, zb + (size_t)(64 * j) * ZP + kcol, zb + (size_t)(64 * j) * ZP + vcol, ZP, w, lane); }
    __syncthreads();
    while (tm) {
        const int j = 31 - __builtin_clz(tm); tm &= ~(1u << j);
        stage_write(sr, L, buf, w, lane);
        __syncthreads();
        if (tm) { const int jn = 31 - __builtin_clz(tm); stage_load(sr, zb + (size_t)(64 * jn) * ZP + kcol, zb + (size_t)(64 * jn) * ZP + vcol, ZP, w, lane); }
        if (j <= jdiag) {
            const int mode = (j == jdiag) ? 1 : ((j == jfar) ? 2 : 0);
            const float off0 = ((lsel >> j) & 1u) ? (slope2 * (float)(64 * j - tq) - st.dl) : -1e30f;
            tile_compute(L + L_K + buf * 8192, L + L_V + buf * 8192, qr, slope2, off0, mode, qq, st, lane);
        }
        buf ^= 1;
    }
}
__device__ __forceinline__ void store_o(bf16_t* dst  , const f32x16& o0, const f32x16& o1, int hi) {
#pragma unroll
    for (int rr = 0; rr < 4; ++rr) {
        u32x2 a; a.x = cvtpk(o0[4 * rr], o0[4 * rr + 1]); a.y = cvtpk(o0[4 * rr + 2], o0[4 * rr + 3]); *(u32x2*)(dst + 8 * rr + 4 * hi) = a;
        u32x2 c; c.x = cvtpk(o1[4 * rr], o1[4 * rr + 1]); c.y = cvtpk(o1[4 * rr + 2], o1[4 * rr + 3]); *(u32x2*)(dst + 32 + 8 * rr + 4 * hi) = c;
    }
}

__device__ __forceinline__ void nsa_unit(bf16_t* Z, const bf16_t* kc, const bf16_t* vc, int b, int g, int qt, LAS unsigned char* L, int tid_, bf16_t* oalt) {
    int tid = tid_; asm volatile("" : "+v"(tid));
    const int lane = tid & 63, w = __builtin_amdgcn_readfirstlane(tid >> 6), r32 = lane & 31, hi = lane >> 5, hg = w >> 1, half = w & 1, h = 4 * g + hg, bg = 2 * b + g;
    const int qq = 32 * half + r32, tq = 64 * qt + qq;
    bf16_t* zrowq = Z + ((size_t)b * S_ + tq) * ZP;
    const bf16_t* zb = Z + (size_t)b * S_ * ZP;
    bf16x8 qr[4];
#pragma unroll
    for (int s = 0; s < 4; ++s) qr[s] = *(const bf16x8*)(zrowq + ZC_QN + h * 64 + 16 * s + 8 * hi);
    const float slope2 = exp2f(-(float)(2 * h + 1) * 0.5f) * LOG2E;
    const float g0 = bf2f(zrowq[ZC_GATE + h * 3 + 0]), g1 = bf2f(zrowq[ZC_GATE + h * 3 + 1]), g2 = bf2f(zrowq[ZC_GATE + h * 3 + 2]);
    f32x16 acc0, acc1;
    const int nc = min(4 * qt + 3, 127), nblk = (nc + 31) >> 5;
    {
        StageRegs s0, s1;
        const bf16_t* kcb = kc + (size_t)bg * 128 * 64; const bf16_t* vcb = vc + (size_t)bg * 128 * 64;
        stage_load(s0, kcb, vcb, 64, w, lane);
        if (nblk > 2) stage_load(s1, kcb + 64 * 64, vcb + 64 * 64, 64, w, lane);
        __syncthreads();
        stage_write(s0, L, 0, w, lane);
        if (nblk > 2) stage_write(s1, L, 1, w, lane);
        __syncthreads();
    }
    const int cmaxq = (tq - 31) >> 4;
    const float s16 = 16.f * slope2;
    float rm = -INFINITY;
#pragma unroll
    for (int blk = 0; blk < 4; ++blk) if (blk < nblk) {
        const float oh = slope2 * (float)(16 * 32 * blk + 31 - tq) + s16 * (float)(4 * hi);
        f32x16 c;
#pragma unroll
        for (int r = 0; r < 16; ++r) c[r] = s16 * (float)((r & 3) + 8 * (r >> 2)) + oh;
        c = qk_block(L + L_K + (blk >> 1) * 8192, blk & 1, qr, c, r32, hi);
#pragma unroll
        for (int r = 0; r < 16; ++r) { if (32 * blk + crow(r, hi) <= cmaxq) rm = fmaxf(rm, c[r]); }
    }
    rm = xmax(rm); if (rm == -INFINITY) rm = 0.f;
    const bool need_imp = qt >= 16;
    LAS float* impA = (LAS float*)(L + L_IMPA) + (hg * 64 + qq) * 33;
    LAS float* impB = (LAS float*)(L + L_IMPB) + (hg * 64 + qq) * 33;
    float lsum = 0.f;
    {
        f32x16 o0, o1;
#pragma unroll
        for (int r = 0; r < 16; ++r) { o0[r] = 0.f; o1[r] = 0.f; }
#pragma unroll
        for (int blk = 0; blk < 4; ++blk) {
            if (blk < nblk) {
                const float oh = slope2 * (float)(16 * 32 * blk + 31 - tq) + s16 * (float)(4 * hi) - rm;
                f32x16 c;
#pragma unroll
                for (int r = 0; r < 16; ++r) c[r] = s16 * (float)((r & 3) + 8 * (r >> 2)) + oh;
                c = qk_block(L + L_K + (blk >> 1) * 8192, blk & 1, qr, c, r32, hi);
#pragma unroll
                for (int r = 0; r < 16; ++r) { const float e = (32 * blk + crow(r, hi) <= cmaxq) ? __builtin_amdgcn_exp2f(c[r]) : 0.f; c[r] = e; lsum += e; }
                pv_step(L + L_V + (blk >> 1) * 8192, 2 * (blk & 1), pack_p(c, 0), o0, o1, lane);
                pv_step(L + L_V + (blk >> 1) * 8192, 2 * (blk & 1) + 1, pack_p(c, 8), o0, o1, lane);
                if (need_imp) {
#pragma unroll
                    for (int rr = 0; rr < 4; ++rr) { const int j = 8 * blk + 2 * rr + hi; impA[j] = (c[4 * rr] + c[4 * rr + 1]) + (c[4 * rr + 2] + c[4 * rr + 3]); if (j + 1 < 32) impB[j + 1] = c[4 * rr + 3]; }
                }
            } else if (need_imp) {
#pragma unroll
                for (int rr = 0; rr < 4; ++rr) { const int j = 8 * blk + 2 * rr + hi; impA[j] = 0.f; if (j + 1 < 32) impB[j + 1] = 0.f; }
            }
        }
        lsum = xsum(lsum);
        const float inv = lsum > 0.f ? 1.f / lsum : 0.f;
        if (need_imp && hi == 0) { ((LAS float*)(L + L_LINV))[hg * 64 + qq] = inv; impB[0] = 0.f; }
        const float sc = g0 * inv;
#pragma unroll
        for (int r = 0; r < 16; ++r) { acc0[r] = sc * o0[r]; acc1[r] = sc * o1[r]; }
    }
    LAS unsigned* selm = (LAS unsigned*)(L + L_SELM);
    if (need_imp) {
        __syncthreads();
        LAS float* impS = (LAS float*)(L + L_IMPS);
        int tid2 = tid; asm volatile("" : "+v"(tid2));
        { const LAS float* A = (const LAS float*)(L + L_IMPA); const LAS float* Bq = (const LAS float*)(L + L_IMPB); const LAS float* LI = (const LAS float*)(L + L_LINV);
#pragma unroll
          for (int k = 0; k < 4; ++k) { const int idx = tid2 + 512 * k, q2 = idx >> 5, j = idx & 31; float sacc = 0.f;
#pragma unroll
              for (int hh = 0; hh < 4; ++hh) sacc += (A[(hh * 64 + q2) * 33 + j] + Bq[(hh * 64 + q2) * 33 + j]) * LI[hh * 64 + q2];
              impS[q2 * 33 + j] = sacc; } }
        __syncthreads();
        { const int q2 = tid2 >> 3, jg = tid2 & 7; const LAS float* row = impS + q2 * 33; unsigned bits = 0u;
#pragma unroll
          for (int jj = 0; jj < 4; ++jj) { const int j = 4 * jg + jj; bool sel = false;
              if (j == 0 || j == qt || j == qt - 1) sel = true;
              else if (j <= qt - 2) { const float v = row[j]; int rank = 0; for (int j2 = 1; j2 <= qt - 2; ++j2) { const float v2 = row[j2]; rank += (v2 > v || (v2 == v && j2 < j)) ? 1 : 0; } sel = rank < 13; }
              bits |= sel ? (1u << j) : 0u; }
          bits |= __shfl_xor(bits, 1); bits |= __shfl_xor(bits, 2); bits |= __shfl_xor(bits, 4);
          if (jg == 0) selm[q2] = bits; }
        __syncthreads();
    } else {
        if (tid < 64) selm[tid] = (2u << qt) - 1u;
        __syncthreads();
    }
    const unsigned myselm = selm[qq];
    unsigned uni = selm[lane];
#pragma unroll
    for (int o = 32; o > 0; o >>= 1) uni |= __shfl_xor(uni, o);
    uni = __builtin_amdgcn_readfirstlane(uni);
    int buf = 0;
    {
        State st; st.dl = 0.f; st.l = 0.f;
#pragma unroll
        for (int r = 0; r < 16; ++r) { st.o0[r] = 0.f; st.o1[r] = 0.f; }
        tile_loop(uni, myselm, qt, -1, zb, ZC_KSLC + g * 64, ZC_VSLC + g * 64, qr, slope2, tq, qq, st, L, buf, w, lane);
        const float sc = g1 / xsum(st.l);
#pragma unroll
        for (int r = 0; r < 16; ++r) { acc0[r] += sc * st.o0[r]; acc1[r] += sc * st.o1[r]; }
    }
    {
        State st; st.dl = 0.f; st.l = 0.f;
#pragma unroll
        for (int r = 0; r < 16; ++r) { st.o0[r] = 0.f; st.o1[r] = 0.f; }
        const int jlo = max(0, qt - 8); const unsigned tm = ((2u << qt) - 1u) & ~((1u << jlo) - 1u);
        tile_loop(tm, 0xffffffffu, qt, qt - 8, zb, ZC_KWIN + g * 64, ZC_VWIN + g * 64, qr, slope2, tq, qq, st, L, buf, w, lane);
        const float sc = g2 / xsum(st.l);
#pragma unroll
        for (int r = 0; r < 16; ++r) { acc0[r] += sc * st.o0[r]; acc1[r] += sc * st.o1[r]; }
    }
    store_o(oalt ? oalt + ((size_t)b * S_ + tq) * D_ + h * 64 : zrowq + ZC_QN + h * 64, acc0, acc1, hi);
    __syncthreads();
}

__device__ __forceinline__ void moba_unit(bf16_t* Z, const float* kmean, int b, int h, int nb, LAS unsigned char* L, int tid_, bf16_t* oalt) {
    int tid = tid_; asm volatile("" : "+v"(tid));
    const int lane = tid & 63, w = __builtin_amdgcn_readfirstlane(tid >> 6), r32 = lane & 31, hi = lane >> 5;
    const int qq = 32 * (w & 1) + r32, tq = 256 * nb + 32 * w + r32;
    bf16_t* zrowq = Z + ((size_t)b * S_ + tq) * ZP;
    const bf16_t* zb = Z + (size_t)b * S_ * ZP;
    bf16x8 qr[4];
#pragma unroll
    for (int s = 0; s < 4; ++s) qr[s] = *(const bf16x8*)(zrowq + ZC_QM + h * 64 + 16 * s + 8 * hi);
    const float slope2 = exp2f(-(float)(h + 1)) * LOG2E;
    LAS float* km = (LAS float*)(L + L_KMEAN); LAS unsigned* misc = (LAS unsigned*)(L + L_MISC);
    km[tid] = kmean[((size_t)b * 8 + h) * 512 + tid];
    if (tid == 0) misc[1] = 0u;
    __syncthreads();
    unsigned lsel = 0u;
    if (nb > 0) {
        float gs[8];
#pragma unroll
        for (int j = 0; j < 8; ++j) {
            float s = 0.f;
            if (j < nb) {
#pragma unroll
                for (int sI = 0; sI < 4; ++sI) { const u32x4 qw = __builtin_bit_cast(u32x4, qr[sI]); const LAS float* kk = km + j * 64 + 16 * sI + 8 * hi;
                    s += bflo(qw.x) * kk[0] + bfhi(qw.x) * kk[1] + bflo(qw.y) * kk[2] + bfhi(qw.y) * kk[3] + bflo(qw.z) * kk[4] + bfhi(qw.z) * kk[5] + bflo(qw.w) * kk[6] + bfhi(qw.w) * kk[7]; }
                s = xsum(s);
            } else s = -1e30f;
            gs[j] = s;
        }
        unsigned bsel = 0u;
#pragma unroll
        for (int j = 0; j < 8; ++j) { int rank = 0;
#pragma unroll
            for (int j2 = 0; j2 < 8; ++j2) rank += (gs[j2] > gs[j] || (gs[j2] == gs[j] && j2 < j)) ? 1 : 0;
            if (j < nb && rank < 3) bsel |= 1u << j; }
#pragma unroll
        for (int j = 0; j < 8; ++j) if ((bsel >> j) & 1u) lsel |= 0xfu << (4 * j);
        unsigned u = bsel;
#pragma unroll
        for (int o = 32; o > 0; o >>= 1) u |= __shfl_xor(u, o);
        if (lane == 0) (void)__hip_atomic_fetch_or(misc + 1, u, __ATOMIC_RELAXED, __HIP_MEMORY_SCOPE_WORKGROUP);
    }
    __syncthreads();
    unsigned ub = misc[1]; ub = __builtin_amdgcn_readfirstlane(ub);
    unsigned tm = 0xfu << (4 * nb);
#pragma unroll
    for (int j = 0; j < 8; ++j) if ((ub >> j) & 1u) tm |= 0xfu << (4 * j);
    lsel |= 0xfu << (4 * nb);
    State st; st.dl = 0.f; st.l = 0.f;
#pragma unroll
    for (int r = 0; r < 16; ++r) { st.o0[r] = 0.f; st.o1[r] = 0.f; }
    int buf = 0;
    tile_loop(tm, lsel, 4 * nb + (w >> 1), -1, zb, ZC_KM + h * 64, ZC_VM + h * 64, qr, slope2, tq, qq, st, L, buf, w, lane);
    const float sc = 1.f / xsum(st.l);
#pragma unroll
    for (int r = 0; r < 16; ++r) { st.o0[r] *= sc; st.o1[r] *= sc; }
    store_o(oalt ? oalt + ((size_t)b * S_ + tq) * D_ + 512 + h * 64 : zrowq + ZC_QM + h * 64, st.o0, st.o1, hi);
    __syncthreads();
}

__device__ __forceinline__ void attn_phase(bf16_t* Z, const bf16_t* kc, const bf16_t* vc, const float* kmean, unsigned* qhead, LAS unsigned char* L, int tid, bf16_t* oalt) {
    LAS unsigned* misc = (LAS unsigned*)(L + L_MISC);
    for (;;) {
        if (tid == 0) misc[0] = atomicAdd(qhead, 1u);
        __syncthreads();
        int u = (int)misc[0]; u = __builtin_amdgcn_readfirstlane(u);
        __syncthreads();
        if (u >= 1024) break;
        int lv = 31;
        for (;; --lv) { const int cnt = 16 + ((lv & 3) == 3 ? 64 : 0); if (u < cnt) break; u -= cnt; }
        if (u < 16) nsa_unit(Z, kc, vc, u >> 1, u & 1, lv, L, tid, oalt);
        else { u -= 16; moba_unit(Z, kmean, u >> 3, u & 7, lv >> 2, L, tid, oalt); }
    }
}
}
namespace fc {
constexpr int SEGB = 2064;
constexpr int L_A = 0, L_X = 17 * SEGB + 48  , L_H = L_X + 8192  , L_END = L_H + 16 * 132 * 4;
static_assert(L_X % 16 == 0 && L_END <= 131072, "cmp LDS");
__device__ __forceinline__ float gelu_t(float x) { const float u = 0.7978845608028654f * (x + 0.044715f * x * x * x); const float e = __builtin_amdgcn_exp2f(2.f * LOG2E * u); return x * (1.f - __builtin_amdgcn_rcpf(1.f + e)); }
__device__ __forceinline__ void cmp_unit(const Args& a, LAS unsigned char* L, int u, int tid_) {
    int tid = tid_; asm volatile("" : "+v"(tid));
    unsigned char* ws = a.ws; const bf16_t* Z = (const bf16_t*)(ws + WS_R);
    const int lane = tid & 63, w = __builtin_amdgcn_readfirstlane(tid >> 6);
    const int kv = u >> 7, bg = (u >> 3) & 15, grp = u & 7, b = bg >> 1, g = bg & 1;
    const int col = (kv ? ZC_VCMP : ZC_KCMP) + g * 64;
    for (int i = tid; i < 272 * 8; i += NTHR) { const int tt = i >> 3, ch = i & 7; const int tok = min(256 * grp + tt, S_ - 1);
        const u32x4 v = *(const u32x4*)(Z + ((size_t)b * S_ + tok) * ZP + col + ch * 8);
        *(LAS u32x4*)(L + L_A + (tt >> 4) * SEGB + (tt & 15) * 128 + ch * 16) = v; }
    __syncthreads();
    const int half = w >> 2, ns = w & 3, m = lane & 15, kg = lane >> 4;
    const bf16_t* w1t = (const bf16_t*)(ws + (kv ? WS_WC1V : WS_WC1K)) + (size_t)(32 * ns + m) * 2048 + half * 1024 + kg * 8;
    const LAS unsigned char* ab = L + L_A + (m + half) * SEGB + kg * 16;
    f32x4 acc0 = (f32x4){0.f, 0.f, 0.f, 0.f}, acc1 = acc0;
#pragma unroll 4
    for (int kk = 0; kk < 32; ++kk) {
        const bf16x8 af = *(const LAS bf16x8*)(ab + (kk >> 1) * 128 + (kk & 1) * 64);
        const bf16x8 b0 = *(const bf16x8*)(w1t + kk * 32), b1 = *(const bf16x8*)(w1t + 16 * 2048 + kk * 32);
        acc0 = __builtin_amdgcn_mfma_f32_16x16x32_bf16(af, b0, acc0, 0, 0, 0);
        acc1 = __builtin_amdgcn_mfma_f32_16x16x32_bf16(af, b1, acc1, 0, 0, 0);
    }
    LAS float* X = (LAS float*)(L + L_X); LAS float* H = (LAS float*)(L + L_H);
    if (half == 1) {
#pragma unroll
        for (int r = 0; r < 4; ++r) { X[(4 * kg + r) * 128 + 32 * ns + m] = acc0[r]; X[(4 * kg + r) * 128 + 32 * ns + 16 + m] = acc1[r]; }
    }
    __syncthreads();
    if (half == 0) {
        const float* bias = (const float*)(ws + WS_CBIAS) + kv * 128;
        const float bz0 = bias[32 * ns + m], bz1 = bias[32 * ns + 16 + m];
#pragma unroll
        for (int r = 0; r < 4; ++r) { const int sg = 4 * kg + r;
            H[sg * 132 + 32 * ns + m] = gelu_t(acc0[r] + X[sg * 128 + 32 * ns + m] + bz0);
            H[sg * 132 + 32 * ns + 16 + m] = gelu_t(acc1[r] + X[sg * 128 + 32 * ns + 16 + m] + bz1); }
    }
    __syncthreads();
    {
        const int sg = tid >> 5, cp = tid & 31; const float* w2 = a.in[kv ? 13 : 10] + 2 * cp; const LAS float* hr = H + sg * 132; float s0 = 0.f, s1 = 0.f;
#pragma unroll 8
        for (int j = 0; j < 128; ++j) { const f32x2_t wv = *(const f32x2_t*)(w2 + j * 64); const float hv = hr[j]; s0 += hv * wv[0]; s1 += hv * wv[1]; }
        const int c = 16 * grp + sg;
        bf16_t* outc = (bf16_t*)(ws + (kv ? WS_VC : WS_KC)) + ((size_t)bg * 128 + c) * 64 + 2 * cp;
        *(unsigned*)outc = (c == 127) ? 0u : cvtpk(s0, s1);
    }
    __syncthreads();
}
__device__ __forceinline__ void kmean_fast(const Args& a, int gw, int ngw, int lane) {
    const bf16_t* Z = (const bf16_t*)(a.ws + WS_R); float* kmean = (float*)(a.ws + WS_KMEAN);
    for (int it = gw; it < 512; it += ngw) {
        const int n = it & 7, h = (it >> 3) & 7, b = it >> 6, rs = lane >> 3, ch = lane & 7;
        float s[8];
#pragma unroll
        for (int i = 0; i < 8; ++i) s[i] = 0.f;
        const bf16_t* base = Z + ((size_t)b * S_ + 256 * n + rs) * ZP + ZC_KM + h * 64 + ch * 8;
#pragma unroll 4
        for (int i = 0; i < 32; ++i) { const u32x4 v = *(const u32x4*)(base + (size_t)(8 * i) * ZP);
            s[0] += bflo(v.x); s[1] += bfhi(v.x); s[2] += bflo(v.y); s[3] += bfhi(v.y); s[4] += bflo(v.z); s[5] += bfhi(v.z); s[6] += bflo(v.w); s[7] += bfhi(v.w); }
#pragma unroll
        for (int i = 0; i < 8; ++i) { s[i] += __shfl_xor(s[i], 8); s[i] += __shfl_xor(s[i], 16); s[i] += __shfl_xor(s[i], 32); }
        if (rs == 0) { f32x4 o0 = (f32x4){s[0], s[1], s[2], s[3]} * (1.f / 256.f), o1 = (f32x4){s[4], s[5], s[6], s[7]} * (1.f / 256.f);
            *(f32x4*)(kmean + (size_t)it * 64 + ch * 8) = o0; *(f32x4*)(kmean + (size_t)it * 64 + ch * 8 + 4) = o1; }
    }
}
}
constexpr int RING_OFF = 0, RING_BYTES = 131072;
constexpr int MISC_OFF = RING_BYTES;
constexpr int LDS_BYTES = 147456;
constexpr int N_PHASES = 12;

__global__ void __launch_bounds__(NTHR, 2) mega(Args args) {
    extern __shared__ __attribute__((aligned(16))) unsigned char lds_raw[];
    LAS unsigned char* lds = (LAS unsigned char*)lds_raw;
    const int tid = threadIdx.x, lane = tid & 63, wave = __builtin_amdgcn_readfirstlane(tid >> 6);
    const int G = gridDim.x, bx = blockIdx.x;
    const int vcu = (G % 8 == 0) ? (bx % 8) * (G / 8) + bx / 8 : bx;
    volatile LAS unsigned* MISC = (volatile LAS unsigned*)(lds + MISC_OFF);
    if (tid < 32) MISC[tid] = 0u;
    __syncthreads();
    unsigned char* ws = args.ws;
    const int lo = args.ph_lo, hi = args.ph_hi;
    XcdBarrier bar; bar.bar = (unsigned*)(ws + WS_CTL) + CW_BAR; bar.x = 0; bar.st = MISC + 8;
    if (hi - lo > 1) bar = xcd_barrier_post((unsigned*)(ws + WS_CTL) + CW_BAR, MISC + 8);
#define IN(k) (lo <= (k) && (k) < hi)
#define SEAM(k) do { if (IN(k) && IN((k) + 1)) xcd_barrier(bar); } while (0)
    float* out = args.out;
    bf16_t* AB = (bf16_t*)(ws + WS_AB); bf16_t* AB2 = (bf16_t*)(ws + WS_AB2); bf16_t* HID = (bf16_t*)(ws + WS_R); bf16_t* Z = (bf16_t*)(ws + WS_R); float* PE = (float*)(ws + WS_R);
    float* SS1 = (float*)(ws + WS_SS); float* SS2 = (float*)(ws + WS_SS + SZ_SS); float* SS3 = (float*)(ws + WS_SS + 2 * SZ_SS); float* SS4 = (float*)(ws + WS_SS + 3 * SZ_SS); float* SS5 = (float*)(ws + WS_SS + 4 * SZ_SS);

    if (IN(0)) { p0_prologue(args, lds, vcu, G, wave, lane, tid);
#if PROBE_DUP == 0
        p0_prologue(args, lds, vcu, G, wave, lane, tid);
#endif
        SEAM(0); }
    if (IN(1)) { pg8::Gemm g{AB, (const bf16_t*)(ws + WS_W13A), D_, D_, M_, 2 * F_, D_}; pg8::StaticOrder S; S.init(M_, 2 * F_, G, bx);
        pg8::EpiSwiglu E{SS1, HID}; pg8::gemm_phase<pg8::EpiSwiglu, pg8::StaticOrder, true>(lds + RING_OFF, g, S, E);
#if PROBE_DUP == 1
        pg8::gemm_phase<pg8::EpiSwiglu, pg8::StaticOrder, true>(lds + RING_OFF, g, S, E);
#endif
        SEAM(1); }
    if (IN(2)) { pg8::Gemm g{HID, (const bf16_t*)(ws + WS_W2A), F_, F_, M_, D_, F_}; pg8::StaticOrder S; S.init(M_, D_, G, bx);
        pg8::EpiRes E{args.in[0], out, AB, SS2, 0.5f}; pg8::gemm_phase<pg8::EpiRes, pg8::StaticOrder, false>(lds + RING_OFF, g, S, E);
#if PROBE_DUP == 2
        pg8::gemm_phase<pg8::EpiRes, pg8::StaticOrder, false>(lds + RING_OFF, g, S, E);
#endif
        SEAM(2); }
    if (IN(3)) { pg8::Gemm g{AB, (const bf16_t*)(ws + WS_WIN), D_, D_, M_, NINP, D_}; pg8::StaticOrder S; S.init(M_, NINP, G, bx);
        pg8::EpiInproj E{SS2, Z}; pg8::gemm_phase<pg8::EpiInproj, pg8::StaticOrder, true>(lds + RING_OFF, g, S, E);
#if PROBE_DUP == 3
        pg8::gemm_phase<pg8::EpiInproj, pg8::StaticOrder, true>(lds + RING_OFF, g, S, E);
#endif
        SEAM(3); }
    if (IN(4)) {
#if defined(CMP_GOLDEN)
        cmp_phase_simple(args, lds, vcu, G, tid); kmean_phase_simple(args, vcu, G, wave, lane);
#else
        for (int u = vcu; u < 256; u += G) fc::cmp_unit(args, lds, u, tid);
        fc::kmean_fast(args, vcu * NWAVES + wave, G * NWAVES, lane);
#if PROBE_DUP == 4
        for (int u = vcu; u < 256; u += G) fc::cmp_unit(args, lds, u, tid);
        fc::kmean_fast(args, vcu * NWAVES + wave, G * NWAVES, lane);
#endif
#endif
        SEAM(4); }
    if (IN(5)) {
        const bf16_t* kc = (const bf16_t*)(ws + WS_KC); const bf16_t* vc = (const bf16_t*)(ws + WS_VC); const float* kmean = (const float*)(ws + WS_KMEAN);
#if defined(ATTN_GOLDEN)
        for (int it = vcu; it < M_; it += G) { nsa_item_simple(Z, kc, vc, it >> 11, it & 2047, (LAS float*)lds, tid); moba_item_simple(Z, kmean, it >> 11, it & 2047, (LAS float*)lds, tid); }
#else
#if PROBE_DUP == 5
        fa::attn_phase(Z, kc, vc, kmean, (unsigned*)(ws + WS_CTL) + CW_QUEUE + 64, lds, tid, AB);
#endif
        fa::attn_phase(Z, kc, vc, kmean, (unsigned*)(ws + WS_CTL) + CW_QUEUE, lds, tid, nullptr);
#endif
        SEAM(5); }
    if (IN(6)) {
        { pg8::Gemm g{Z + ZC_QN, (const bf16_t*)(ws + WS_WUPN), ZP, 512, M_, D_, 512}; pg8::StaticOrder S; S.init(M_, D_, G, bx);
          pg8::EpiUpmix<0> E{Z, AB}; pg8::gemm_phase<pg8::EpiUpmix<0>, pg8::StaticOrder, false>(lds + RING_OFF, g, S, E); }
        { pg8::Gemm g{Z + ZC_QM, (const bf16_t*)(ws + WS_WUPM), ZP, 512, M_, D_, 512}; pg8::StaticOrder S; S.init(M_, D_, G, bx);
          pg8::EpiUpmix<1> E{Z, AB}; pg8::gemm_phase<pg8::EpiUpmix<1>, pg8::StaticOrder, false>(lds + RING_OFF, g, S, E); }
        SEAM(6); }
    if (IN(7)) { pg8::Gemm g{AB, (const bf16_t*)(ws + WS_WOUT), D_, D_, M_, D_, D_}; pg8::StaticOrder S; S.init(M_, D_, G, bx);
        pg8::EpiRes E{out, out, AB2, SS3, 1.0f}; pg8::gemm_phase<pg8::EpiRes, pg8::StaticOrder, false>(lds + RING_OFF, g, S, E); SEAM(7); }
    if (IN(8)) { pg8::Gemm g{AB2, (const bf16_t*)(ws + WS_W13B), D_, D_, M_, 2 * F_, D_}; pg8::StaticOrder S; S.init(M_, 2 * F_, G, bx);
        pg8::EpiSwiglu E{SS3, HID}; pg8::gemm_phase<pg8::EpiSwiglu, pg8::StaticOrder, true>(lds + RING_OFF, g, S, E); SEAM(8); }
    if (IN(9)) { pg8::Gemm g{HID, (const bf16_t*)(ws + WS_W2B), F_, F_, M_, D_, F_}; pg8::StaticOrder S; S.init(M_, D_, G, bx);
        pg8::EpiRes E{out, out, AB, SS4, 0.5f}; pg8::gemm_phase<pg8::EpiRes, pg8::StaticOrder, false>(lds + RING_OFF, g, S, E); SEAM(9); }
    if (IN(10)) {
        { pg8::Gemm g{(const bf16_t*)(ws + WS_PB), (const bf16_t*)(ws + WS_WPLE), PLE_, PLE_, M_, D_, PLE_}; pg8::StaticOrder S; S.init(M_, D_, G, bx);
          pg8::EpiPe E{PE}; pg8::gemm_phase<pg8::EpiPe, pg8::StaticOrder, false>(lds + RING_OFF, g, S, E); }
        { pg8::Gemm g{AB, (const bf16_t*)(ws + WS_WPG), D_, D_, M_, D_, D_}; pg8::StaticOrder S; S.init(M_, D_, G, bx);
          pg8::EpiPle E{SS4, PE, out, SS5}; pg8::gemm_phase<pg8::EpiPle, pg8::StaticOrder, false>(lds + RING_OFF, g, S, E); }
        SEAM(10); }
    if (IN(11)) {
        const f32x4* gn = (const f32x4*)args.in[24] + lane;
        for (int row = vcu * NWAVES + wave; row < M_; row += G * NWAVES) {
            const float rs = pg8::rs_from_ss(SS5, row, lane >> 4);
            f32x4* hr = (f32x4*)(out + (size_t)row * D_) + lane;
#pragma unroll
            for (int j = 0; j < 4; ++j) { f32x4 v = hr[64 * j]; const f32x4 gg = gn[64 * j]; v = v * gg * rs; hr[64 * j] = v; }
        }
    }
#undef IN
#undef SEAM
}
}

extern "C" void kernel_launch(void* const* d_in, const int* in_sizes, int n_in, void* d_out, int out_size, void* d_ws, size_t ws_size, hipStream_t stream) {
    static int grid = 0;
    if (grid == 0) {
        if (n_in != 25 || ws_size < WS_END || out_size != M_ * D_) { fprintf(stderr, "kernel_launch: unexpected n_in %d / out_size %d / ws_size %zu (need %zu)\n", n_in, out_size, ws_size, (size_t)WS_END); grid = -1; return; }
        int dev = 0, cus = 0, per_cu = 0;
        if (hipGetDevice(&dev) != hipSuccess || hipDeviceGetAttribute(&cus, hipDeviceAttributeMultiprocessorCount, dev) != hipSuccess) { grid = -1; return; }
        if (hipFuncSetAttribute((const void*)mega, hipFuncAttributeMaxDynamicSharedMemorySize, LDS_BYTES) != hipSuccess) { fprintf(stderr, "kernel_launch: hipFuncSetAttribute failed\n"); grid = -1; return; }
        if (hipOccupancyMaxActiveBlocksPerMultiprocessor(&per_cu, (const void*)mega, NTHR, LDS_BYTES) != hipSuccess || per_cu < 1) fprintf(stderr, "kernel_launch: occupancy query reports %d\n", per_cu);
        (void)hipGetLastError();
        grid = cus;
    }
    if (grid < 0) return;
    (void)hipMemsetAsync((char*)d_ws + WS_CTL, 0, CTL_ZERO_BYTES, stream);
    Args a{};
    for (int i = 0; i < 25; ++i) a.in[i] = (const float*)d_in[i];
    a.out = (float*)d_out; a.ws = (unsigned char*)d_ws;
#if MK_N_LAUNCHES == 1
    a.ph_lo = 0; a.ph_hi = N_PHASES;
    hipLaunchKernelGGL(mega, dim3(grid), dim3(NTHR), LDS_BYTES, stream, a);
#else
    for (int k = 0; k < N_PHASES; ++k) { a.ph_lo = k; a.ph_hi = k + 1; hipLaunchKernelGGL(mega, dim3(grid), dim3(NTHR), LDS_BYTES, stream, a); }
#endif
}
```

```cpp
#include <hip/hip_runtime.h>
#include <cstdint>
#include <cstdio>

#ifndef PROBE_DUP
#define PROBE_DUP -1
#endif
#ifndef MK_N_LAUNCHES
#define MK_N_LAUNCHES 1
#endif

namespace {
typedef unsigned short bf16_t;
#define LAS __attribute__((address_space(3)))
#define GAS __attribute__((address_space(1)))
typedef short bf16x8 __attribute__((ext_vector_type(8)));
typedef float f32x4 __attribute__((ext_vector_type(4)));
typedef float f32x16 __attribute__((ext_vector_type(16)));
typedef unsigned u32x4 __attribute__((ext_vector_type(4)));
typedef unsigned u32x2 __attribute__((ext_vector_type(2)));

constexpr int B_ = 8, S_ = 2048, D_ = 1024, M_ = B_ * S_;
constexpr int F_ = 2816, NIN = 4888, NINP = 5120, PLE_ = 256;
constexpr int ZP = NIN;
constexpr int ZC_QN = 0, ZC_KCMP = 512, ZC_VCMP = 640, ZC_KSLC = 768, ZC_VSLC = 896, ZC_KWIN = 1024, ZC_VWIN = 1152,
              ZC_GATE = 1280, ZC_QM = 1304, ZC_KM = 1816, ZC_VM = 2328, ZC_GA = 2840, ZC_GB = 3864;
constexpr float LOG2E = 1.4426950408889634f;
constexpr float C2 = 0.125f * LOG2E;
constexpr int NWAVES = 8, NTHR = 512;

constexpr size_t MiB = 1u << 20;
constexpr size_t WS_CTL = 0, CTL_ZERO_BYTES = 64 * 1024;
constexpr size_t WS_W13A = 1 * MiB;
constexpr size_t SZ_W13 = (size_t)2 * F_ * D_ * 2, SZ_W2 = (size_t)D_ * F_ * 2;
constexpr size_t WS_W2A = WS_W13A + SZ_W13;
constexpr size_t WS_W13B = WS_W2A + SZ_W2;
constexpr size_t WS_W2B = WS_W13B + SZ_W13;
constexpr size_t WS_WIN = WS_W2B + SZ_W2;
constexpr size_t WS_WUPN = WS_WIN + (size_t)NINP * D_ * 2;
constexpr size_t WS_WUPM = WS_WUPN + (size_t)D_ * 512 * 2;
constexpr size_t WS_WOUT = WS_WUPM + (size_t)D_ * 512 * 2;
constexpr size_t WS_WPG = WS_WOUT + (size_t)D_ * D_ * 2;
constexpr size_t WS_WPLE = WS_WPG + (size_t)D_ * D_ * 2;
constexpr size_t WS_WC1K = WS_WPLE + (size_t)D_ * PLE_ * 2;
constexpr size_t WS_WC1V = WS_WC1K + (size_t)128 * 2048 * 2;
constexpr size_t WS_CBIAS = WS_WC1V + (size_t)128 * 2048 * 2;
constexpr size_t WS_KC = WS_CBIAS + 4096;
constexpr size_t WS_VC = WS_KC + (size_t)16 * 128 * 64 * 2;
constexpr size_t WS_KMEAN = WS_VC + (size_t)16 * 128 * 64 * 2;
constexpr size_t WS_SS = WS_KMEAN + (size_t)8 * 8 * 8 * 64 * 4;
constexpr size_t SZ_SS = (size_t)M_ * 16 * 4;
constexpr size_t WS_AB = WS_SS + 5 * SZ_SS;
constexpr size_t WS_PB = WS_AB + (size_t)M_ * D_ * 2;
constexpr size_t WS_R = WS_PB + (size_t)M_ * PLE_ * 2;
constexpr size_t SZ_Z = (size_t)M_ * ZP * 2, SZ_HID = (size_t)M_ * F_ * 2;
constexpr size_t WS_AB2 = WS_R + SZ_HID;
constexpr size_t WS_END = WS_R + SZ_Z;
static_assert(WS_AB2 + (size_t)M_ * D_ * 2 <= WS_END, "AB2 inside R");
static_assert((size_t)M_ * D_ * 4 <= SZ_Z, "pe temp inside R");
static_assert(WS_END <= 256 * MiB, "workspace map must fit 256 MiB");
static_assert((WS_R % 256) == 0 && (WS_AB % 256) == 0 && (WS_KC % 256) == 0 && (WS_SS % 256) == 0, "alignment");

__device__ __forceinline__ float bf2f(bf16_t v) { return __uint_as_float(((unsigned)v) << 16); }
__device__ __forceinline__ float bflo(unsigned u) { return __uint_as_float(u << 16); }
__device__ __forceinline__ float bfhi(unsigned u) { return __uint_as_float(u & 0xffff0000u); }
__device__ __forceinline__ unsigned f2bf(float f) { unsigned u = __float_as_uint(f); return (u + 0x7fffu + ((u >> 16) & 1u)) >> 16; }
__device__ __forceinline__ unsigned pk2(float lo, float hi) { return f2bf(lo) | (f2bf(hi) << 16); }
typedef float f32x2_t __attribute__((ext_vector_type(2)));
typedef __bf16 bf16x2_t __attribute__((ext_vector_type(2)));
__device__ __forceinline__ unsigned cvtpk(float lo, float hi) { f32x2_t v = {lo, hi}; bf16x2_t b = __builtin_convertvector(v, bf16x2_t); return __builtin_bit_cast(unsigned, b); }
__device__ __forceinline__ float wsum(float v) {
#pragma unroll
    for (int o = 32; o > 0; o >>= 1) v += __shfl_xor(v, o);
    return v;
}
__device__ __forceinline__ float wmax(float v) {
#pragma unroll
    for (int o = 32; o > 0; o >>= 1) v = fmaxf(v, __shfl_xor(v, o));
    return v;
}
__device__ __forceinline__ float fsigmoid(float x) { return __builtin_amdgcn_rcpf(1.f + __builtin_amdgcn_exp2f(-LOG2E * x)); }
namespace pg8 {
constexpr int BM = 256, BK = 64, HALF = 128, HTB = HALF * BK * 2  , STAGE_BYTES = 8 * HTB, NXCD = 8, WGM = 8;
__host__ __device__ __forceinline__ int lds_byte(int r, int c) { const int st = (r >> 4) * 2 + (c >> 5), rr = r & 15, cc = c & 31, ob = rr * 64 + cc * 2; return st * 1024 + (ob ^ (((ob >> 9) & 1) << 5)); }
__host__ __device__ __forceinline__ void stage_rc(int b, int& R, int& C) { const int st = b / 1024, sb = b % 1024, swz = sb ^ (((sb >> 9) & 1) << 5); R = (st >> 1) * 16 + swz / 64; C = (st & 1) * 32 + (swz % 64) / 2; }
__host__ __device__ __forceinline__ int perm32(int rho) { const int n = rho >> 4, i = rho & 15; return 8 * (i >> 2) + 4 * n + (i & 3); }

struct Unit { int pm, pn; };
struct Gemm { const bf16_t* A; const bf16_t* Bt; int lda, ldb, M, N, K; };

struct StaticOrder {
    int nM, nN, nwg, G, c;
    __host__ __device__ void init(int M, int N, int G_, int c_) { nM = M / BM; nN = N / BM; nwg = nM * nN; G = G_; c = c_; }
    __host__ __device__ bool next(int i, Unit& u) const {
        const long L = (long)i * G + c; if (L >= nwg) return false;
        int wgid = (int)L; { const int q = nwg / NXCD, r = nwg % NXCD, xcd = wgid % NXCD, off = wgid / NXCD; wgid = (xcd < r ? xcd * (q + 1) : r * (q + 1) + (xcd - r) * q) + off; }
        const int nig = WGM * nN, gid = wgid / nig, fm = gid * WGM, gsz = (nM - fm) < WGM ? (nM - fm) : WGM;
        u.pm = fm + ((wgid % nig) % gsz); u.pn = (wgid % nig) / gsz; return true;
    }
};

__device__ __forceinline__ float rs_from_ss(const float* ss, int row, int fq) {
    const f32x4 v = *(const f32x4*)(ss + (size_t)row * 16 + 4 * fq);
    float s = (v[0] + v[1]) + (v[2] + v[3]); s += __shfl_xor(s, 16); s += __shfl_xor(s, 32);
    return rsqrtf(s * (1.f / 1024.f) + 1e-6f);
}
__device__ __forceinline__ u32x4 pack8(const f32x4& a, const f32x4& b) { u32x4 w; w.x = cvtpk(a[0], a[1]); w.y = cvtpk(a[2], a[3]); w.z = cvtpk(b[0], b[1]); w.w = cvtpk(b[2], b[3]); return w; }

struct EpiSwiglu {
    static constexpr bool PERM = true;
    const float* ss; bf16_t* hid;
    __device__ __forceinline__ void operator()(const f32x4 (&acc)[2][2][4][2], const Unit& u, int wr, int wc, int fr, int fq) const {
        const int row0 = u.pm * BM + wr * 64 + fr, col0 = u.pn * 128 + wc * 32 + 8 * fq;
#pragma unroll
        for (int ai = 0; ai < 2; ++ai)
#pragma unroll
            for (int m = 0; m < 4; ++m) {
                const int row = row0 + ai * HALF + m * 16; const float rs = rs_from_ss(ss, row, fq);
                f32x4 h[2];
#pragma unroll
                for (int n = 0; n < 2; ++n) { const f32x4 a = acc[ai][0][m][n] * rs, b = acc[ai][1][m][n] * rs;
#pragma unroll
                    for (int i = 0; i < 4; ++i) h[n][i] = a[i] * b[i] * fsigmoid(a[i]); }
                *(u32x4*)(hid + (size_t)row * F_ + col0) = pack8(h[0], h[1]);
            }
    }
};
struct EpiRes {
    static constexpr bool PERM = true;
    const float* resid; float* outf; bf16_t* outb; float* ssout; float coef;
    __device__ __forceinline__ void operator()(const f32x4 (&acc)[2][2][4][2], const Unit& u, int wr, int wc, int fr, int fq) const {
        const int row0 = u.pm * BM + wr * 64 + fr, col0 = u.pn * BM + wc * 32 + 8 * fq;
#pragma unroll
        for (int ai = 0; ai < 2; ++ai)
#pragma unroll
            for (int m = 0; m < 4; ++m) {
                const int row = row0 + ai * HALF + m * 16; float sq = 0.f;
#pragma unroll
                for (int bj = 0; bj < 2; ++bj) {
                    const size_t off = (size_t)row * D_ + col0 + bj * HALF;
                    const f32x4 r0 = *(const f32x4*)(resid + off), r1 = *(const f32x4*)(resid + off + 4);
                    const f32x4 v0 = r0 + acc[ai][bj][m][0] * coef, v1 = r1 + acc[ai][bj][m][1] * coef;
                    *(f32x4*)(outf + off) = v0; *(f32x4*)(outf + off + 4) = v1;
                    *(u32x4*)(outb + off) = pack8(v0, v1);
                    sq += (v0[0] * v0[0] + v0[1] * v0[1]) + (v0[2] * v0[2] + v0[3] * v0[3]) + (v1[0] * v1[0] + v1[1] * v1[1]) + (v1[2] * v1[2] + v1[3] * v1[3]);
                }
                sq += __shfl_xor(sq, 16); sq += __shfl_xor(sq, 32);
                if (fq == 0) ssout[(size_t)row * 16 + u.pn * 4 + wc] = sq;
            }
    }
};
struct EpiInproj {
    static constexpr bool PERM = true;
    const float* ss; bf16_t* Z;
    __device__ __forceinline__ void operator()(const f32x4 (&acc)[2][2][4][2], const Unit& u, int wr, int wc, int fr, int fq) const {
        const int row0 = u.pm * BM + wr * 64 + fr, col0 = u.pn * BM + wc * 32 + 8 * fq;
#pragma unroll
        for (int ai = 0; ai < 2; ++ai)
#pragma unroll
            for (int m = 0; m < 4; ++m) {
                const int row = row0 + ai * HALF + m * 16; const float rs = rs_from_ss(ss, row, fq);
#pragma unroll
                for (int bj = 0; bj < 2; ++bj) {
                    const int col = col0 + bj * HALF;
                    if (col < NIN) {
                        f32x4 v0 = acc[ai][bj][m][0] * rs, v1 = acc[ai][bj][m][1] * rs;
                        if ((col >= ZC_GATE && col < ZC_QM) || col >= ZC_GA) {
#pragma unroll
                            for (int i = 0; i < 4; ++i) { v0[i] = fsigmoid(v0[i]); v1[i] = fsigmoid(v1[i]); }
                        }
                        *(u32x4*)(Z + (size_t)row * ZP + col) = pack8(v0, v1);
                    }
                }
            }
    }
};
template <int PASS> struct EpiUpmix {
    static constexpr bool PERM = true;
    const bf16_t* Z; bf16_t* outb;
    __device__ __forceinline__ void operator()(const f32x4 (&acc)[2][2][4][2], const Unit& u, int wr, int wc, int fr, int fq) const {
        const int row0 = u.pm * BM + wr * 64 + fr, col0 = u.pn * BM + wc * 32 + 8 * fq;
#pragma unroll
        for (int ai = 0; ai < 2; ++ai)
#pragma unroll
            for (int m = 0; m < 4; ++m) {
                const int row = row0 + ai * HALF + m * 16;
#pragma unroll
                for (int bj = 0; bj < 2; ++bj) {
                    const int col = col0 + bj * HALF;
                    const u32x4 gw = *(const u32x4*)(Z + (size_t)row * ZP + (PASS ? ZC_GB : ZC_GA) + col);
                    f32x4 v0, v1;
                    v0[0] = bflo(gw.x) * acc[ai][bj][m][0][0]; v0[1] = bfhi(gw.x) * acc[ai][bj][m][0][1]; v0[2] = bflo(gw.y) * acc[ai][bj][m][0][2]; v0[3] = bfhi(gw.y) * acc[ai][bj][m][0][3];
                    v1[0] = bflo(gw.z) * acc[ai][bj][m][1][0]; v1[1] = bfhi(gw.z) * acc[ai][bj][m][1][1]; v1[2] = bflo(gw.w) * acc[ai][bj][m][1][2]; v1[3] = bfhi(gw.w) * acc[ai][bj][m][1][3];
                    bf16_t* o = outb + (size_t)row * D_ + col;
                    if (PASS) { const u32x4 t = *(const u32x4*)o;
                        v0[0] += bflo(t.x); v0[1] += bfhi(t.x); v0[2] += bflo(t.y); v0[3] += bfhi(t.y); v1[0] += bflo(t.z); v1[1] += bfhi(t.z); v1[2] += bflo(t.w); v1[3] += bfhi(t.w); }
                    *(u32x4*)o = pack8(v0, v1);
                }
            }
    }
};
struct EpiPe {
    static constexpr bool PERM = true;
    float* pe;
    __device__ __forceinline__ void operator()(const f32x4 (&acc)[2][2][4][2], const Unit& u, int wr, int wc, int fr, int fq) const {
        const int row0 = u.pm * BM + wr * 64 + fr, col0 = u.pn * BM + wc * 32 + 8 * fq;
#pragma unroll
        for (int ai = 0; ai < 2; ++ai)
#pragma unroll
            for (int m = 0; m < 4; ++m)
#pragma unroll
                for (int bj = 0; bj < 2; ++bj) { const size_t off = (size_t)(row0 + ai * HALF + m * 16) * D_ + col0 + bj * HALF;
                    *(f32x4*)(pe + off) = acc[ai][bj][m][0]; *(f32x4*)(pe + off + 4) = acc[ai][bj][m][1]; }
    }
};
struct EpiPle {
    static constexpr bool PERM = true;
    const float* ss; const float* pe; float* h; float* ssout;
    __device__ __forceinline__ void operator()(const f32x4 (&acc)[2][2][4][2], const Unit& u, int wr, int wc, int fr, int fq) const {
        const int row0 = u.pm * BM + wr * 64 + fr, col0 = u.pn * BM + wc * 32 + 8 * fq;
#pragma unroll
        for (int ai = 0; ai < 2; ++ai)
#pragma unroll
            for (int m = 0; m < 4; ++m) {
                const int row = row0 + ai * HALF + m * 16; const float rs = rs_from_ss(ss, row, fq); float sq = 0.f;
#pragma unroll
                for (int bj = 0; bj < 2; ++bj) {
                    const size_t off = (size_t)row * D_ + col0 + bj * HALF;
#pragma unroll
                    for (int n = 0; n < 2; ++n) {
                        const f32x4 r = *(const f32x4*)(h + off + 4 * n), p = *(const f32x4*)(pe + off + 4 * n); f32x4 v;
#pragma unroll
                        for (int i = 0; i < 4; ++i) { v[i] = r[i] + fsigmoid(acc[ai][bj][m][n][i] * rs) * p[i]; sq += v[i] * v[i]; }
                        *(f32x4*)(h + off + 4 * n) = v;
                    }
                }
                sq += __shfl_xor(sq, 16); sq += __shfl_xor(sq, 32);
                if (fq == 0) ssout[(size_t)row * 16 + u.pn * 4 + wc] = sq;
            }
    }
};

template <class Epi, class Sched, bool ALIGN_EPI>
__device__ __forceinline__ void gemm_phase(LAS unsigned char* lds, const Gemm g, const Sched& S, const Epi& E) {
    const int tid = threadIdx.x, wid = __builtin_amdgcn_readfirstlane(tid >> 6), lane = tid & 63, wr = wid >> 2, wc = wid & 3, fr = lane & 15, fq = lane >> 4;
    const int K = g.K, nt = K / BK;
    unsigned voffA[2], voffB[2];
#pragma unroll
    for (int i = 0; i < 2; ++i) { int R, C; stage_rc(tid * 16 + i * 8192, R, C); const int Rb = Epi::PERM ? ((R & ~31) + perm32(R & 31)) : R;
        voffA[i] = (unsigned)(R * g.lda + C) * 2u; voffB[i] = (unsigned)(Rb * g.ldb + C) * 2u; }
    const size_t kstep = (size_t)(BK * 2);
    const size_t hstepA = (size_t)HALF * g.lda * 2, hstepB = (size_t)HALF * g.ldb * 2;
    const size_t tstepA = 2 * hstepA, tstepB = 2 * hstepB;
    const unsigned ldsw = (unsigned)wid * 1024u;
    const int aoff = lds_byte(wr * 64 + fr, fq * 8), boff = lds_byte(wc * 32 + fr, fq * 8);
#define PG8_SA(b, h) (((b) * 2 + (h)) * HTB)
#define PG8_SB(b, h) ((4 + (b) * 2 + (h)) * HTB)
#define PG8_STAGE(bufoff, gbase, voff) do { _Pragma("unroll") for (int _i = 0; _i < 2; ++_i) \
        __builtin_amdgcn_global_load_lds((const unsigned*)((const char*)(gbase) + (voff)[_i]), (LAS unsigned*)(lds + (bufoff) + ldsw + _i * 8192), 16, 0, 0); } while (0)
#define PG8_LDA(dst, b, h) do { _Pragma("unroll") for (int m = 0; m < 4; ++m) _Pragma("unroll") for (int k = 0; k < 2; ++k) dst[m][k] = *(const LAS bf16x8*)(lds + PG8_SA(b, h) + aoff + m * 2048 + k * 1024); } while (0)
#define PG8_LDB(dst, b, h) do { _Pragma("unroll") for (int n = 0; n < 2; ++n) _Pragma("unroll") for (int k = 0; k < 2; ++k) dst[n][k] = *(const LAS bf16x8*)(lds + PG8_SB(b, h) + boff + n * 2048 + k * 1024); } while (0)
#define PG8_MMA(ai, bj, At, Bt) do { __builtin_amdgcn_s_setprio(1); _Pragma("unroll") for (int m = 0; m < 4; ++m) _Pragma("unroll") for (int n = 0; n < 2; ++n) _Pragma("unroll") for (int k = 0; k < 2; ++k) \
        acc[ai][bj][m][n] = __builtin_amdgcn_mfma_f32_16x16x32_bf16(Bt[n][k], At[m][k], acc[ai][bj][m][n], 0, 0, 0); __builtin_amdgcn_s_setprio(0); } while (0)
#define PG8_WAIT_V(n) asm volatile("s_waitcnt vmcnt(" #n ")" ::: "memory")
#define PG8_WAIT_L(n) asm volatile("s_waitcnt lgkmcnt(" #n ")" ::: "memory")
#define PG8_BAR __builtin_amdgcn_s_barrier()
#define PG8_SCHED __builtin_amdgcn_sched_barrier(0)
    Unit cur, nxt; int ui = 0;
    if (!S.next(0, cur)) return;
    f32x4 acc[2][2][4][2];
#pragma unroll
    for (int a = 0; a < 2; ++a)
#pragma unroll
        for (int b = 0; b < 2; ++b)
#pragma unroll
            for (int m = 0; m < 4; ++m)
#pragma unroll
                for (int n = 0; n < 2; ++n) acc[a][b][m][n] = (f32x4){0.f, 0.f, 0.f, 0.f};
    bf16x8 At[4][2], B0[2][2], B1[2][2];
    const char* cA = (const char*)g.A + (size_t)cur.pm * tstepA; const char* cB = (const char*)g.Bt + (size_t)cur.pn * tstepB;
    PG8_STAGE(PG8_SB(0, 0), cB, voffB); PG8_STAGE(PG8_SB(0, 1), cB + hstepB, voffB); PG8_STAGE(PG8_SA(0, 0), cA, voffA); PG8_STAGE(PG8_SA(0, 1), cA + hstepA, voffA);
    if (wr == 1) PG8_BAR;
    PG8_WAIT_V(2); PG8_BAR;
    PG8_STAGE(PG8_SB(1, 0), cB + kstep, voffB); PG8_STAGE(PG8_SA(1, 0), cA + kstep, voffA); PG8_STAGE(PG8_SB(1, 1), cB + hstepB + kstep, voffB);
    PG8_WAIT_V(6); PG8_BAR;
    for (;;) {
        const bool has_next = S.next(ui + 1, nxt);
        const char* nA = has_next ? (const char*)g.A + (size_t)nxt.pm * tstepA : cA; const char* nB = has_next ? (const char*)g.Bt + (size_t)nxt.pn * tstepB : cB;
        for (int t = 0; t < nt; t += 2) {
            const bool last = (t == nt - 2);
            const char* a1 = cA + (size_t)(t + 1) * kstep;
            const char* a2 = last ? nA : cA + (size_t)(t + 2) * kstep; const char* b2 = last ? nB : cB + (size_t)(t + 2) * kstep;
            const char* a3 = a2 + kstep; const char* b3 = b2 + kstep;
            PG8_LDB(B0, 0, 0); PG8_LDB(B1, 0, 1); PG8_SCHED; PG8_LDA(At, 0, 0); PG8_STAGE(PG8_SA(1, 1), a1 + hstepA, voffA);
            PG8_WAIT_V(8); PG8_WAIT_L(0); PG8_BAR; PG8_MMA(0, 0, At, B0); PG8_MMA(0, 1, At, B1); PG8_BAR; PG8_SCHED;
            PG8_LDA(At, 0, 1); PG8_STAGE(PG8_SB(0, 0), b2, voffB); PG8_STAGE(PG8_SB(0, 1), b2 + hstepB, voffB); PG8_STAGE(PG8_SA(0, 0), a2, voffA);
            PG8_WAIT_V(8); PG8_WAIT_L(0); PG8_BAR; PG8_MMA(1, 0, At, B0); PG8_MMA(1, 1, At, B1); PG8_BAR; PG8_SCHED;
            PG8_LDB(B0, 1, 0); PG8_LDB(B1, 1, 1); PG8_SCHED; PG8_LDA(At, 1, 0); PG8_STAGE(PG8_SA(0, 1), a2 + hstepA, voffA);
            PG8_WAIT_V(8); PG8_WAIT_L(0); PG8_BAR; PG8_MMA(0, 0, At, B0); PG8_MMA(0, 1, At, B1); PG8_BAR; PG8_SCHED;
            PG8_LDA(At, 1, 1); PG8_STAGE(PG8_SB(1, 0), b3, voffB); PG8_STAGE(PG8_SB(1, 1), b3 + hstepB, voffB); PG8_STAGE(PG8_SA(1, 0), a3, voffA);
            PG8_WAIT_V(8); PG8_WAIT_L(0); PG8_BAR; PG8_MMA(1, 0, At, B0); PG8_MMA(1, 1, At, B1); PG8_BAR; PG8_SCHED;
        }
        if constexpr (ALIGN_EPI) { if (wr == 0) PG8_BAR; }
        E(acc, cur, wr, wc, fr, fq);
        if (!has_next) break;
#pragma unroll
        for (int a = 0; a < 2; ++a)
#pragma unroll
            for (int b = 0; b < 2; ++b)
#pragma unroll
                for (int m = 0; m < 4; ++m)
#pragma unroll
                    for (int n = 0; n < 2; ++n) acc[a][b][m][n] = (f32x4){0.f, 0.f, 0.f, 0.f};
        cur = nxt; cA = nA; cB = nB; ++ui;
        if constexpr (ALIGN_EPI) { if (wr == 1) PG8_BAR; }
    }
    PG8_WAIT_V(0);
    if constexpr (!ALIGN_EPI) { if (wr == 0) PG8_BAR; }
    PG8_BAR;
#undef PG8_SA
#undef PG8_SB
#undef PG8_STAGE
#undef PG8_LDA
#undef PG8_LDB
#undef PG8_MMA
#undef PG8_WAIT_V
#undef PG8_WAIT_L
#undef PG8_BAR
#undef PG8_SCHED
}
}
typedef GAS unsigned gu32;
#define RLX_AGENT __ATOMIC_RELAXED, __HIP_MEMORY_SCOPE_AGENT
#define LDS_WAIT() asm volatile("s_waitcnt lgkmcnt(0)" ::: "memory")
#define VM_WAIT() asm volatile("s_waitcnt vmcnt(0)" ::: "memory")
#define XB_TMO      128
#define XB_XCNT(j)  (256  + 64 * (j))
#define XB_XSUB(j)  (1280 + 64 * (j))
#define XB_XGEN(j)  (2304 + 64 * (j))
#define XB_TOP      3328
#define XB_TOPGEN   3392
#define XCD_BAR_WORDS 3456
#define XB_SPIN_CAP (1u << 20)
constexpr int CW_BAR = 1024;
constexpr int CW_QUEUE = 8192;
static_assert((CW_BAR + XCD_BAR_WORDS) * 4 <= (int)CTL_ZERO_BYTES && (CW_QUEUE + 64 * 8) * 4 <= (int)CTL_ZERO_BYTES, "ctl words inside the memset region");

__device__ __forceinline__ unsigned xb_ld(unsigned* p)              { return __hip_atomic_load(p, __ATOMIC_RELAXED, __HIP_MEMORY_SCOPE_AGENT); }
__device__ __forceinline__ unsigned xb_add(unsigned* p, unsigned v) { return __hip_atomic_fetch_add(p, v, __ATOMIC_RELAXED, __HIP_MEMORY_SCOPE_AGENT); }
__device__ __forceinline__ unsigned xb_xcc_id() { return (unsigned)__builtin_amdgcn_s_getreg((3 << 11) | 20) & 0xFu; }
#define XB_SPIN(cond, bar) do { unsigned _sp = 0; while (cond) { __builtin_amdgcn_s_sleep(1); \
    if ((++_sp & 255u) == 0u) { if (xb_ld(&(bar)[XB_TMO])) break; if (_sp > XB_SPIN_CAP) { atomicAdd(&(bar)[XB_TMO], 1u); break; } } } } while (0)

struct XcdBarrier { unsigned* bar; unsigned x; volatile LAS unsigned* st; };
__device__ __forceinline__ XcdBarrier xcd_barrier_post(unsigned* bar, volatile LAS unsigned* st) {
    XcdBarrier b; b.bar = bar; b.x = xb_xcc_id(); b.st = st;
    if (threadIdx.x == 0) (void)xb_add(&bar[XB_XCNT(b.x)], 1u);
    return b;
}
__device__ __forceinline__ void xcd_barrier_complete(unsigned* bar, unsigned x, unsigned& nloc, unsigned& nx) {
    const unsigned G = gridDim.x * gridDim.y * gridDim.z;
    unsigned sum, cnt, mine, sp = 0u;
    for (;;) {
        sum = 0u; cnt = 0u; mine = 0u;
#pragma unroll
        for (unsigned j = 0; j < 16; ++j) { const unsigned c = xb_ld(&bar[XB_XCNT(j)]); sum += c; cnt += (c > 0u) ? 1u : 0u; mine = (j == x) ? c : mine; }
        if (sum == G) break;
        __builtin_amdgcn_s_sleep(1);
        if ((++sp & 255u) == 0u) { if (xb_ld(&bar[XB_TMO])) break; if (sp > XB_SPIN_CAP) { atomicAdd(&bar[XB_TMO], 1u); break; } }
    }
    nloc = mine > 0u ? mine : 1u; nx = cnt > 0u ? cnt : 1u;
}
__device__ __forceinline__ void xcd_barrier(const XcdBarrier& b) {
    asm volatile("s_waitcnt vmcnt(0)" ::: "memory");
    __syncthreads();
    if (threadIdx.x == 0) {
        unsigned* bar = b.bar;
        __builtin_amdgcn_s_waitcnt(0);
        unsigned nloc = b.st[0], nx = b.st[1];
        if (nloc == 0u) { xcd_barrier_complete(bar, b.x, nloc, nx); b.st[0] = nloc; b.st[1] = nx; }
        const unsigned old = xb_add(&bar[XB_XSUB(b.x)], 1u);
        const unsigned gen = old / nloc;
        if (old + 1u == (gen + 1u) * nloc) {
            __builtin_amdgcn_fence(__ATOMIC_RELEASE, "agent");
            asm volatile("s_waitcnt vmcnt(0)" ::: "memory");
            const unsigned og = xb_add(&bar[XB_TOP], 1u);
            const unsigned tg = og / nx;
            if (og + 1u == (tg + 1u) * nx) xb_add(&bar[XB_TOPGEN], 1u);
            else XB_SPIN(xb_ld(&bar[XB_TOPGEN]) == tg, bar);
            __builtin_amdgcn_fence(__ATOMIC_ACQUIRE, "agent");
            xb_add(&bar[XB_XGEN(b.x)], 1u);
            asm volatile("s_waitcnt vmcnt(0)" ::: "memory");
        } else {
            XB_SPIN(xb_ld(&bar[XB_XGEN(b.x)]) == gen, bar);
            __builtin_amdgcn_fence(__ATOMIC_ACQUIRE, "agent");
            asm volatile("s_waitcnt vmcnt(0)" ::: "memory");
        }
    }
    __syncthreads();
}

struct Args { const float* in[25]; float* out; unsigned char* ws; int ph_lo, ph_hi; };
static_assert(sizeof(Args) == 25 * 8 + 8 + 8 + 8, "no padding");

__device__ __forceinline__ void tr_item(const float* W, const float* gain, bf16_t* Wt, int K, int N, int mode, int roff, bool qscale, LAS float* scr, int item, int lane) {
    const int nblk = (N + 31) >> 5, kb = item / nblk, nb = item - kb * nblk, k0 = 64 * kb, n0 = 32 * nb;
    const int n = n0 + (lane & 31); const bool ok = n < N;
    const float* src = W + (size_t)(k0 + (lane >> 5)) * N + (ok ? n : 0);
    float v[32];
#pragma unroll
    for (int i = 0; i < 32; ++i) v[i] = src[(size_t)(2 * i) * N];
#pragma unroll
    for (int i = 0; i < 32; ++i) scr[(2 * i + (lane >> 5)) * 33 + (lane & 31)] = ok ? v[i] : 0.f;
    LDS_WAIT(); asm volatile("" ::: "memory");
    const int c = lane & 7;
    f32x4 g0 = (f32x4){1.f, 1.f, 1.f, 1.f}, g1 = g0;
    if (gain) { g0 = *(const f32x4*)(gain + k0 + 8 * c); g1 = *(const f32x4*)(gain + k0 + 8 * c + 4); }
#pragma unroll
    for (int j = 0; j < 4; ++j) {
        const int nl = (lane >> 3) + 8 * j, nn = n0 + nl;
        if (nn < N) {
            const LAS float* s = scr + (8 * c) * 33 + nl;
            const float sc = (qscale && ((nn >= ZC_QN && nn < ZC_QN + 512) || (nn >= ZC_QM && nn < ZC_QM + 512))) ? C2 : 1.f;
            u32x4 o;
            o.x = pk2(s[0 * 33] * g0[0] * sc, s[1 * 33] * g0[1] * sc); o.y = pk2(s[2 * 33] * g0[2] * sc, s[3 * 33] * g0[3] * sc);
            o.z = pk2(s[4 * 33] * g1[0] * sc, s[5 * 33] * g1[1] * sc); o.w = pk2(s[6 * 33] * g1[2] * sc, s[7 * 33] * g1[3] * sc);
            const int drow = mode ? ((nn >> 7) * 256 + (nn & 127) + roff) : nn;
            *(u32x4*)(Wt + (size_t)drow * K + k0 + 8 * c) = o;
        }
    }
    LDS_WAIT(); asm volatile("" ::: "memory");
}
constexpr int trcnt(int K, int N) { return (K / 64) * ((N + 31) / 32); }
constexpr int I_W13 = trcnt(D_, F_), I_W2 = trcnt(F_, D_), I_WIN = trcnt(D_, NIN), I_WUP = trcnt(512, D_), I_WDD = trcnt(D_, D_), I_WPLE = trcnt(PLE_, D_), I_WC1 = trcnt(2048, 128);
constexpr int TR_NITEMS = 4 * I_W13 + 2 * I_W2 + I_WIN + 2 * I_WUP + 2 * I_WDD + I_WPLE + 2 * I_WC1;

__device__ __forceinline__ void p0_prologue(const Args& a, LAS unsigned char* lds, int vcu, int G, int wave, int lane, int tid) {
    unsigned char* ws = a.ws;
    LAS float* scr = (LAS float*)(lds + wave * 16384);
    const int gw = vcu * NWAVES + wave, NGW = G * NWAVES;
    for (int it = gw; it < TR_NITEMS; it += NGW) {
        int r = it;
        if (r < I_W13) { tr_item(a.in[3], a.in[2], (bf16_t*)(ws + WS_W13A), D_, F_, 1, 0, false, scr, r, lane); continue; } r -= I_W13;
        if (r < I_W13) { tr_item(a.in[4], a.in[2], (bf16_t*)(ws + WS_W13A), D_, F_, 1, 128, false, scr, r, lane); continue; } r -= I_W13;
        if (r < I_W2) { tr_item(a.in[5], nullptr, (bf16_t*)(ws + WS_W2A), F_, D_, 0, 0, false, scr, r, lane); continue; } r -= I_W2;
        if (r < I_W13) { tr_item(a.in[18], a.in[17], (bf16_t*)(ws + WS_W13B), D_, F_, 1, 0, false, scr, r, lane); continue; } r -= I_W13;
        if (r < I_W13) { tr_item(a.in[19], a.in[17], (bf16_t*)(ws + WS_W13B), D_, F_, 1, 128, false, scr, r, lane); continue; } r -= I_W13;
        if (r < I_W2) { tr_item(a.in[20], nullptr, (bf16_t*)(ws + WS_W2B), F_, D_, 0, 0, false, scr, r, lane); continue; } r -= I_W2;
        if (r < I_WIN) { tr_item(a.in[7], a.in[6], (bf16_t*)(ws + WS_WIN), D_, NIN, 0, 0, true, scr, r, lane); continue; } r -= I_WIN;
        if (r < I_WUP) { tr_item(a.in[14], nullptr, (bf16_t*)(ws + WS_WUPN), 512, D_, 0, 0, false, scr, r, lane); continue; } r -= I_WUP;
        if (r < I_WUP) { tr_item(a.in[15], nullptr, (bf16_t*)(ws + WS_WUPM), 512, D_, 0, 0, false, scr, r, lane); continue; } r -= I_WUP;
        if (r < I_WDD) { tr_item(a.in[16], nullptr, (bf16_t*)(ws + WS_WOUT), D_, D_, 0, 0, false, scr, r, lane); continue; } r -= I_WDD;
        if (r < I_WDD) { tr_item(a.in[22], a.in[21], (bf16_t*)(ws + WS_WPG), D_, D_, 0, 0, false, scr, r, lane); continue; } r -= I_WDD;
        if (r < I_WPLE) { tr_item(a.in[23], nullptr, (bf16_t*)(ws + WS_WPLE), PLE_, D_, 0, 0, false, scr, r, lane); continue; } r -= I_WPLE;
        if (r < I_WC1) { tr_item(a.in[9], nullptr, (bf16_t*)(ws + WS_WC1K), 2048, 128, 0, 0, false, scr, r, lane); continue; } r -= I_WC1;
        tr_item(a.in[12], nullptr, (bf16_t*)(ws + WS_WC1V), 2048, 128, 0, 0, false, scr, r, lane);
    }
    { const float* x = a.in[0]; bf16_t* xb = (bf16_t*)(ws + WS_AB); float* ss = (float*)(ws + WS_SS);
      for (int row = gw; row < M_; row += 2 * NGW) {
          const int row2 = row + NGW; const bool has2 = row2 < M_;
          const f32x4* xr = (const f32x4*)(x + (size_t)row * D_) + lane; const f32x4* xr2 = (const f32x4*)(x + (size_t)(has2 ? row2 : row) * D_) + lane;
          f32x4 va[4], vb[4];
#pragma unroll
          for (int j = 0; j < 4; ++j) { va[j] = xr[64 * j]; vb[j] = xr2[64 * j]; }
          u32x2* o = (u32x2*)(xb + (size_t)row * D_) + lane; u32x2* o2 = (u32x2*)(xb + (size_t)row2 * D_) + lane; float s = 0.f, s2 = 0.f;
#pragma unroll
          for (int j = 0; j < 4; ++j) { const f32x4 v = va[j]; s += (v[0] * v[0] + v[1] * v[1]) + (v[2] * v[2] + v[3] * v[3]); u32x2 w; w.x = cvtpk(v[0], v[1]); w.y = cvtpk(v[2], v[3]); o[64 * j] = w; }
          if (has2) {
#pragma unroll
              for (int j = 0; j < 4; ++j) { const f32x4 v = vb[j]; s2 += (v[0] * v[0] + v[1] * v[1]) + (v[2] * v[2] + v[3] * v[3]); u32x2 w; w.x = cvtpk(v[0], v[1]); w.y = cvtpk(v[2], v[3]); o2[64 * j] = w; }
          }
          s = wsum(s); s2 = wsum(s2);
          if (lane < 16) { ss[(size_t)row * 16 + lane] = lane == 0 ? s : 0.f; if (has2) ss[(size_t)row2 * 16 + lane] = lane == 0 ? s2 : 0.f; }
      } }
    { const f32x4* p = (const f32x4*)a.in[1]; u32x4* pb = (u32x4*)(ws + WS_PB); const int gt = vcu * NTHR + tid, NGT = G * NTHR;
      for (int i = gt; i < M_ * PLE_ / 8; i += NGT) { const f32x4 u = p[2 * i], v = p[2 * i + 1]; u32x4 o; o.x = cvtpk(u[0], u[1]); o.y = cvtpk(u[2], u[3]); o.z = cvtpk(v[0], v[1]); o.w = cvtpk(v[2], v[3]); pb[i] = o; }
      u32x4* wz = (u32x4*)(ws + WS_WIN + (size_t)NIN * D_ * 2);
      for (int i = gt; i < (NINP - NIN) * D_ * 2 / 16; i += NGT) wz[i] = (u32x4){0u, 0u, 0u, 0u}; }
    if (gw < 256) { const int kv = gw >> 7, j = gw & 127; const float* pos = a.in[kv ? 11 : 8]; const float* w1 = a.in[kv ? 12 : 9]; float s = 0.f;
        for (int i = lane; i < 2048; i += 64) s += pos[i] * w1[(size_t)i * 128 + j];
        s = wsum(s); if (lane == 0) ((float*)(ws + WS_CBIAS))[gw] = s; }
}

__device__ __forceinline__ float gelu_tanh(float x) { const float u = 0.7978845608028654f * (x + 0.044715f * x * x * x); return 0.5f * x * (1.f + tanhf(u)); }
__device__ __forceinline__ float dot64(const LAS float* q, const bf16_t* row) {
    const u32x4* r = (const u32x4*)row; float s = 0.f;
#pragma unroll
    for (int i = 0; i < 8; ++i) { const u32x4 v = r[i]; const LAS float* qq = q + 8 * i;
        s += qq[0] * bflo(v.x) + qq[1] * bfhi(v.x) + qq[2] * bflo(v.y) + qq[3] * bfhi(v.y) + qq[4] * bflo(v.z) + qq[5] * bfhi(v.z) + qq[6] * bflo(v.w) + qq[7] * bfhi(v.w); }
    return s;
}
__device__ __forceinline__ void chunk_step(const LAS float* q, const bf16_t* kbase, const bf16_t* vbase, int kpos0, int t, int kmin, float slope2, int lane, float& m, float& l, float& o) {
    const int kpos = kpos0 + lane; const bool ok = kpos <= t && kpos >= kmin;
    float s = -1e30f;
    if (ok) s = dot64(q, kbase + (size_t)lane * ZP) - slope2 * (float)(t - kpos);
    const float mn = fmaxf(m, wmax(s)); const float alpha = exp2f(m - mn); const float p = ok ? exp2f(s - mn) : 0.f;
    l = l * alpha + wsum(p); o *= alpha; m = mn;
    for (int key = 0; key < 64; ++key) { const float pk = __shfl(p, key); if (pk != 0.f) o += pk * bf2f(vbase[(size_t)key * ZP + lane]); }
}
__device__ __forceinline__ void cmp_phase_simple(const Args& a, LAS unsigned char* lds, int vcu, int G, int tid) {
    unsigned char* ws = a.ws; const bf16_t* Z = (const bf16_t*)(ws + WS_R);
    const int sub = tid >> 7, st = tid & 127;
    LAS float* xin = (LAS float*)lds + sub * 2048; LAS float* hid = (LAS float*)(lds + 32768) + sub * 128;
    for (int it0 = vcu * 4; it0 < 4096; it0 += G * 4) {
        const int it = it0 + sub, kv = it >> 11, bg = (it >> 7) & 15, c = it & 127, b = bg >> 1, g = bg & 1;
        bf16_t* outc = (bf16_t*)(ws + (kv ? WS_VC : WS_KC)) + ((size_t)bg * 128 + c) * 64;
        const int coloff = (kv ? ZC_VCMP : ZC_KCMP) + g * 64;
        if (c < 127) for (int i = st; i < 2048; i += 128) { const int l = i >> 6, d = i & 63; xin[i] = bf2f(Z[((size_t)b * S_ + 16 * c + l) * ZP + coloff + d]); }
        __syncthreads();
        if (c < 127) {
            const bf16_t* w1 = (const bf16_t*)(ws + (kv ? WS_WC1V : WS_WC1K)) + (size_t)st * 2048;
            float acc = ((const float*)(ws + WS_CBIAS))[kv * 128 + st];
            for (int i = 0; i < 2048; i += 8) { const u32x4 w = *(const u32x4*)(w1 + i);
                acc += xin[i] * bflo(w.x) + xin[i + 1] * bfhi(w.x) + xin[i + 2] * bflo(w.y) + xin[i + 3] * bfhi(w.y) + xin[i + 4] * bflo(w.z) + xin[i + 5] * bfhi(w.z) + xin[i + 6] * bflo(w.w) + xin[i + 7] * bfhi(w.w); }
            hid[st] = gelu_tanh(acc);
        }
        __syncthreads();
        if (st < 64) { float s = 0.f; if (c < 127) { const float* w2 = a.in[kv ? 13 : 10]; for (int j = 0; j < 128; ++j) s += hid[j] * w2[j * 64 + st]; } outc[st] = (bf16_t)f2bf(s); }
        __syncthreads();
    }
}
__device__ __forceinline__ void kmean_phase_simple(const Args& a, int vcu, int G, int wave, int lane) {
    const bf16_t* Z = (const bf16_t*)(a.ws + WS_R); float* kmean = (float*)(a.ws + WS_KMEAN);
    for (int it = vcu * NWAVES + wave; it < 512; it += G * NWAVES) {
        const int n = it & 7, h = (it >> 3) & 7, b = it >> 6; float s = 0.f;
        for (int i = 0; i < 256; ++i) s += bf2f(Z[((size_t)b * S_ + 256 * n + i) * ZP + ZC_KM + h * 64 + lane]);
        kmean[(size_t)it * 64 + lane] = s * (1.f / 256.f);
    }
}
__device__ __forceinline__ void nsa_item_simple(bf16_t* Z, const bf16_t* kc, const bf16_t* vc, int b, int t, LAS float* L, int tid) {
    const int lane = tid & 63, h = tid >> 6, g = h >> 2, bg = b * 2 + g;
    LAS float* q_s = L; LAS float* p_s = L + 512; LAS float* imp_s = L + 1536; LAS unsigned* mask_s = (LAS unsigned*)(L + 1600);
    bf16_t* zrow = Z + ((size_t)b * S_ + t) * ZP;
    q_s[h * 64 + lane] = bf2f(zrow[ZC_QN + h * 64 + lane]);
    const float slope2 = exp2f(-(float)(2 * h + 1) * 0.5f) * LOG2E;
    __syncthreads();
    const LAS float* q = q_s + h * 64;
    const int ncv = t >= 31 ? ((t - 31) >> 4) + 1 : 0;
    const bool ok0 = lane < ncv, ok1 = lane + 64 < ncv;
    float s0 = -1e30f, s1 = -1e30f;
    if (ok0) s0 = dot64(q, kc + ((size_t)bg * 128 + lane) * 64) - slope2 * (float)(t - (16 * lane + 31));
    if (ok1) s1 = dot64(q, kc + ((size_t)bg * 128 + lane + 64) * 64) - slope2 * (float)(t - (16 * (lane + 64) + 31));
    const float mc = wmax(fmaxf(s0, s1));
    const float e0 = ok0 ? exp2f(s0 - mc) : 0.f, e1 = ok1 ? exp2f(s1 - mc) : 0.f;
    const float lc = wsum(e0 + e1), inv = 1.f / fmaxf(lc, 1e-30f);
    p_s[h * 128 + lane] = e0 * inv; p_s[h * 128 + lane + 64] = e1 * inv;
    __syncthreads();
    if (tid < 64) {
        const int gg = tid >> 5, j = tid & 31, lo = max(0, 4 * j - 1), hi = min(126, 4 * j + 3); float s = 0.f;
        for (int hh = 0; hh < 4; ++hh) for (int c = lo; c <= hi; ++c) s += p_s[(gg * 4 + hh) * 128 + c];
        imp_s[gg * 32 + j] = s;
    }
    __syncthreads();
    const int cur = t >> 6;
    if (tid < 64) {
        const int gg = lane >> 5, j = lane & 31;
        const bool causal = j <= cur, forced = (j == 0) || (j == cur) || (j == cur - 1);
        const float val = !causal ? -1e30f : (forced ? 1e9f : imp_s[gg * 32 + j]);
        int rank = 0;
        for (int jj = 0; jj < 32; ++jj) {
            const bool cj = jj <= cur, fj = (jj == 0) || (jj == cur) || (jj == cur - 1);
            const float vv = !cj ? -1e30f : (fj ? 1e9f : imp_s[gg * 32 + jj]);
            rank += (vv > val || (vv == val && jj < j)) ? 1 : 0;
        }
        const unsigned long long bal = __ballot(rank < 16 && causal);
        if (lane == 0) { mask_s[0] = (unsigned)bal; mask_s[1] = (unsigned)(bal >> 32); }
    }
    __syncthreads();
    const unsigned mask = mask_s[g];
    float oc = 0.f;
    for (int c = 0; c < ncv; ++c) oc += p_s[h * 128 + c] * bf2f(vc[((size_t)bg * 128 + c) * 64 + lane]);
    const bf16_t* zb = Z + (size_t)b * S_ * ZP;
    float ms = -1e30f, ls = 0.f, os = 0.f;
    for (int j = 0; j <= cur; ++j) {
        if (!((mask >> j) & 1u)) continue;
        chunk_step(q, zb + (size_t)(64 * j) * ZP + ZC_KSLC + g * 64, zb + (size_t)(64 * j) * ZP + ZC_VSLC + g * 64, 64 * j, t, 0, slope2, lane, ms, ls, os);
    }
    float mw = -1e30f, lw = 0.f, ow = 0.f;
    const int kmin = max(0, t - 511);
    for (int k0 = kmin & ~63; k0 <= t; k0 += 64)
        chunk_step(q, zb + (size_t)k0 * ZP + ZC_KWIN + g * 64, zb + (size_t)k0 * ZP + ZC_VWIN + g * 64, k0, t, kmin, slope2, lane, mw, lw, ow);
    const float g0 = bf2f(zrow[ZC_GATE + h * 3 + 0]), g1 = bf2f(zrow[ZC_GATE + h * 3 + 1]), g2 = bf2f(zrow[ZC_GATE + h * 3 + 2]);
    const float o = g0 * oc + g1 * (os / ls) + g2 * (ow / lw);
    zrow[ZC_QN + h * 64 + lane] = (bf16_t)f2bf(o);
    __syncthreads();
}
__device__ __forceinline__ void moba_item_simple(bf16_t* Z, const float* kmean, int b, int t, LAS float* L, int tid) {
    const int lane = tid & 63, h = tid >> 6;
    bf16_t* zrow = Z + ((size_t)b * S_ + t) * ZP;
    const float qv = bf2f(zrow[ZC_QM + h * 64 + lane]);
    L[h * 64 + lane] = qv;
    const float slope2 = exp2f(-(float)(h + 1)) * LOG2E;
    __syncthreads();
    const LAS float* q = L + h * 64;
    const int cur = t >> 8;
    float gs[8];
#pragma unroll
    for (int j = 0; j < 8; ++j) { gs[j] = -1e30f; if (j < cur) gs[j] = wsum(qv * kmean[(((size_t)b * 8 + h) * 8 + j) * 64 + lane]); }
    unsigned sel = 0;
#pragma unroll
    for (int j = 0; j < 8; ++j) {
        int rank = 0;
#pragma unroll
        for (int jj = 0; jj < 8; ++jj) rank += (gs[jj] > gs[j] || (gs[jj] == gs[j] && jj < j)) ? 1 : 0;
        if (j < cur && rank < 3) sel |= 1u << j;
    }
    const bf16_t* zb = Z + (size_t)b * S_ * ZP;
    float m = -1e30f, l = 0.f, o = 0.f;
    for (int j = 0; j < cur; ++j) {
        if (!((sel >> j) & 1u)) continue;
        for (int k0 = 256 * j; k0 < 256 * j + 256; k0 += 64)
            chunk_step(q, zb + (size_t)k0 * ZP + ZC_KM + h * 64, zb + (size_t)k0 * ZP + ZC_VM + h * 64, k0, t, 0, slope2, lane, m, l, o);
    }
    for (int k0 = 256 * cur; k0 <= t; k0 += 64)
        chunk_step(q, zb + (size_t)k0 * ZP + ZC_KM + h * 64, zb + (size_t)k0 * ZP + ZC_VM + h * 64, k0, t, 0, slope2, lane, m, l, o);
    zrow[ZC_QM + h * 64 + lane] = (bf16_t)f2bf(o / l);
    __syncthreads();
}
namespace fa {
constexpr int L_K = 0, L_V = 16384, L_IMPA = 32768  , L_IMPB = L_IMPA + 33792  , L_IMPS = L_IMPB + 33792  , L_SELM = L_IMPS + 8448  ,
              L_MISC = L_SELM + 256  , L_KMEAN = L_MISC + 64  , L_LINV = L_KMEAN + 2048  , L_END = L_LINV + 1024;
static_assert(L_END <= 131072, "attention LDS inside the ring region");
constexpr float THR = 12.f;

__device__ __forceinline__ int crow(int r, int hi) { return (r & 3) + 8 * (r >> 2) + 4 * hi; }
__device__ __forceinline__ float xmax(float v) { auto rr = __builtin_amdgcn_permlane32_swap(__float_as_uint(v), __float_as_uint(v), false, false); return fmaxf(__uint_as_float(rr[0]), __uint_as_float(rr[1])); }
__device__ __forceinline__ float xsum(float v) { auto rr = __builtin_amdgcn_permlane32_swap(__float_as_uint(v), __float_as_uint(v), false, false); return __uint_as_float(rr[0]) + __uint_as_float(rr[1]); }
typedef short v4i16_t __attribute__((ext_vector_type(4)));
typedef short s16x4 __attribute__((ext_vector_type(4)));
__device__ __forceinline__ s16x4 vtr(const LAS unsigned char* p) { return __builtin_bit_cast(s16x4, __builtin_amdgcn_ds_read_tr16_b64_v4i16((LAS v4i16_t*)p)); }

struct StageRegs { u32x4 k, v; };
__device__ __forceinline__ void stage_load(StageRegs& s, const bf16_t* Kb, const bf16_t* Vb, int pitch, int w, int lane) {
    s.k = *(const u32x4*)(Kb + (size_t)lane * pitch + w * 8);
    s.v = *(const u32x4*)(Vb + (size_t)(16 * (w & 3) + (lane >> 2)) * pitch + (w >> 2) * 32 + (lane & 3) * 8);
}
__device__ __forceinline__ void stage_write(const StageRegs& s, LAS unsigned char* L, int buf, int w, int lane) {
    *(LAS u32x4*)(L + L_K + buf * 8192 + w * 1024 + lane * 16) = s.k;
    *(LAS u32x4*)(L + L_V + buf * 8192 + w * 1024 + lane * 16) = s.v;
}
__device__ __forceinline__ f32x16 qk_block(const LAS unsigned char* kslot, int blk, const bf16x8 (&qr)[4], f32x16 c, int r32, int hi) {
    const LAS unsigned char* kb = kslot + hi * 1024 + r32 * 16 + blk * 512;
#pragma unroll
    for (int s = 0; s < 4; ++s) { const bf16x8 kf = *(const LAS bf16x8*)(kb + s * 2048); c = __builtin_amdgcn_mfma_f32_32x32x16_bf16(kf, qr[s], c, 0, 0, 0); }
    return c;
}
__device__ __forceinline__ void pv_step(const LAS unsigned char* vslot, int ks, bf16x8 pf, f32x16& o0, f32x16& o1, int lane) {
    const int hi = lane >> 5;
    const LAS unsigned char* vb = vslot + ((lane >> 4) & 1) * 32 + (lane & 3) * 8 + (4 * hi + ((lane & 15) >> 2)) * 64 + ks * 1024;
    const s16x4 a0 = vtr(vb), a1 = vtr(vb + 512), b0 = vtr(vb + 4096), b1 = vtr(vb + 4096 + 512);
    const bf16x8 v0 = (bf16x8){a0[0], a0[1], a0[2], a0[3], a1[0], a1[1], a1[2], a1[3]}, v1 = (bf16x8){b0[0], b0[1], b0[2], b0[3], b1[0], b1[1], b1[2], b1[3]};
    o0 = __builtin_amdgcn_mfma_f32_32x32x16_bf16(v0, pf, o0, 0, 0, 0);
    o1 = __builtin_amdgcn_mfma_f32_32x32x16_bf16(v1, pf, o1, 0, 0, 0);
}
__device__ __forceinline__ bf16x8 pack_p(const f32x16& p, int base) {
    u32x4 w; w.x = cvtpk(p[base], p[base + 1]); w.y = cvtpk(p[base + 2], p[base + 3]); w.z = cvtpk(p[base + 4], p[base + 5]); w.w = cvtpk(p[base + 6], p[base + 7]);
    return __builtin_bit_cast(bf16x8, w);
}
struct State { float dl, l; f32x16 o0, o1; };
__device__ __forceinline__ void tile_compute(const LAS unsigned char* kslot, const LAS unsigned char* vslot, const bf16x8 (&qr)[4], float slope2, float off0, int mode, int qq, State& st, int lane) {
    const int r32 = lane & 31, hi = lane >> 5;
    f32x16 p0, p1;
    { const float oh0 = off0 + slope2 * (float)(4 * hi), oh1 = oh0 + slope2 * 32.f;
#pragma unroll
      for (int r = 0; r < 16; ++r) { const float cr = (float)((r & 3) + 8 * (r >> 2)); p0[r] = slope2 * cr + oh0; p1[r] = slope2 * cr + oh1; } }
    p0 = qk_block(kslot, 0, qr, p0, r32, hi);
    p1 = qk_block(kslot, 1, qr, p1, r32, hi);
    if (mode) {
        const bool causal = (mode == 1);
#pragma unroll
        for (int r = 0; r < 16; ++r) { const int d0 = crow(r, hi) - qq; if ((d0 <= 0) != causal) p0[r] = -INFINITY; if ((d0 + 32 <= 0) != causal) p1[r] = -INFINITY; }
    }
    float rm = fmaxf(p0[0], p1[0]);
#pragma unroll
    for (int r = 1; r < 16; ++r) rm = fmaxf(rm, fmaxf(p0[r], p1[r]));
    rm = xmax(rm);
    if (__any(rm > THR)) {
        const float d = fmaxf(rm, 0.f), f = __builtin_amdgcn_exp2f(-d);
        st.dl += d; st.l *= f;
#pragma unroll
        for (int r = 0; r < 16; ++r) { p0[r] -= d; p1[r] -= d; st.o0[r] *= f; st.o1[r] *= f; }
    }
    float sm = 0.f;
#pragma unroll
    for (int r = 0; r < 16; ++r) { p0[r] = __builtin_amdgcn_exp2f(p0[r]); p1[r] = __builtin_amdgcn_exp2f(p1[r]); sm += p0[r] + p1[r]; }
    st.l += sm;
    pv_step(vslot, 0, pack_p(p0, 0), st.o0, st.o1, lane);
    pv_step(vslot, 1, pack_p(p0, 8), st.o0, st.o1, lane);
    pv_step(vslot, 2, pack_p(p1, 0), st.o0, st.o1, lane);
    pv_step(vslot, 3, pack_p(p1, 8), st.o0, st.o1, lane);
}
__device__ __forceinline__ void tile_loop(unsigned tm, unsigned lsel, int jdiag, int jfar, const bf16_t* zb, int kcol, int vcol, const bf16x8 (&qr)[4], float slope2, int tq, int qq,
                                          State& st, LAS unsigned char* L, int& buf, int w, int lane) {
    StageRegs sr;
    if (tm) { const int j = 31 - __builtin_clz(tm); stage_load(sr, zb + (size_t)(64 * j) * ZP + kcol, zb + (size_t)(64 * j) * ZP + vcol, ZP, w, lane); }
    __syncthreads();
    while (tm) {
        const int j = 31 - __builtin_clz(tm); tm &= ~(1u << j);
        stage_write(sr, L, buf, w, lane);
        __syncthreads();
        if (tm) { const int jn = 31 - __builtin_clz(tm); stage_load(sr, zb + (size_t)(64 * jn) * ZP + kcol, zb + (size_t)(64 * jn) * ZP + vcol, ZP, w, lane); }
        if (j <= jdiag) {
            const int mode = (j == jdiag) ? 1 : ((j == jfar) ? 2 : 0);
            const float off0 = ((lsel >> j) & 1u) ? (slope2 * (float)(64 * j - tq) - st.dl) : -1e30f;
            tile_compute(L + L_K + buf * 8192, L + L_V + buf * 8192, qr, slope2, off0, mode, qq, st, lane);
        }
        buf ^= 1;
    }
}
__device__ __forceinline__ void store_o(bf16_t* dst  , const f32x16& o0, const f32x16& o1, int hi) {
#pragma unroll
    for (int rr = 0; rr < 4; ++rr) {
        u32x2 a; a.x = cvtpk(o0[4 * rr], o0[4 * rr + 1]); a.y = cvtpk(o0[4 * rr + 2], o0[4 * rr + 3]); *(u32x2*)(dst + 8 * rr + 4 * hi) = a;
        u32x2 c; c.x = cvtpk(o1[4 * rr], o1[4 * rr + 1]); c.y = cvtpk(o1[4 * rr + 2], o1[4 * rr + 3]); *(u32x2*)(dst + 32 + 8 * rr + 4 * hi) = c;
    }
}

__device__ __forceinline__ void nsa_unit(bf16_t* Z, const bf16_t* kc, const bf16_t* vc, int b, int g, int qt, LAS unsigned char* L, int tid_, bf16_t* oalt) {
    int tid = tid_; asm volatile("" : "+v"(tid));
    const int lane = tid & 63, w = __builtin_amdgcn_readfirstlane(tid >> 6), r32 = lane & 31, hi = lane >> 5, hg = w >> 1, half = w & 1, h = 4 * g + hg, bg = 2 * b + g;
    const int qq = 32 * half + r32, tq = 64 * qt + qq;
    bf16_t* zrowq = Z + ((size_t)b * S_ + tq) * ZP;
    const bf16_t* zb = Z + (size_t)b * S_ * ZP;
    bf16x8 qr[4];
#pragma unroll
    for (int s = 0; s < 4; ++s) qr[s] = *(const bf16x8*)(zrowq + ZC_QN + h * 64 + 16 * s + 8 * hi);
    const float slope2 = exp2f(-(float)(2 * h + 1) * 0.5f) * LOG2E;
    const float g0 = bf2f(zrowq[ZC_GATE + h * 3 + 0]), g1 = bf2f(zrowq[ZC_GATE + h * 3 + 1]), g2 = bf2f(zrowq[ZC_GATE + h * 3 + 2]);
    f32x16 acc0, acc1;
    const int nc = min(4 * qt + 3, 127), nblk = (nc + 31) >> 5;
    {
        StageRegs s0, s1;
        const bf16_t* kcb = kc + (size_t)bg * 128 * 64; const bf16_t* vcb = vc + (size_t)bg * 128 * 64;
        stage_load(s0, kcb, vcb, 64, w, lane);
        if (nblk > 2) stage_load(s1, kcb + 64 * 64, vcb + 64 * 64, 64, w, lane);
        __syncthreads();
        stage_write(s0, L, 0, w, lane);
        if (nblk > 2) stage_write(s1, L, 1, w, lane);
        __syncthreads();
    }
    const int cmaxq = (tq - 31) >> 4;
    const float s16 = 16.f * slope2;
    float rm = -INFINITY;
#pragma unroll
    for (int blk = 0; blk < 4; ++blk) if (blk < nblk) {
        const float oh = slope2 * (float)(16 * 32 * blk + 31 - tq) + s16 * (float)(4 * hi);
        f32x16 c;
#pragma unroll
        for (int r = 0; r < 16; ++r) c[r] = s16 * (float)((r & 3) + 8 * (r >> 2)) + oh;
        c = qk_block(L + L_K + (blk >> 1) * 8192, blk & 1, qr, c, r32, hi);
#pragma unroll
        for (int r = 0; r < 16; ++r) { if (32 * blk + crow(r, hi) <= cmaxq) rm = fmaxf(rm, c[r]); }
    }
    rm = xmax(rm); if (rm == -INFINITY) rm = 0.f;
    const bool need_imp = qt >= 16;
    LAS float* impA = (LAS float*)(L + L_IMPA) + (hg * 64 + qq) * 33;
    LAS float* impB = (LAS float*)(L + L_IMPB) + (hg * 64 + qq) * 33;
    float lsum = 0.f;
    {
        f32x16 o0, o1;
#pragma unroll
        for (int r = 0; r < 16; ++r) { o0[r] = 0.f; o1[r] = 0.f; }
#pragma unroll
        for (int blk = 0; blk < 4; ++blk) {
            if (blk < nblk) {
                const float oh = slope2 * (float)(16 * 32 * blk + 31 - tq) + s16 * (float)(4 * hi) - rm;
                f32x16 c;
#pragma unroll
                for (int r = 0; r < 16; ++r) c[r] = s16 * (float)((r & 3) + 8 * (r >> 2)) + oh;
                c = qk_block(L + L_K + (blk >> 1) * 8192, blk & 1, qr, c, r32, hi);
#pragma unroll
                for (int r = 0; r < 16; ++r) { const float e = (32 * blk + crow(r, hi) <= cmaxq) ? __builtin_amdgcn_exp2f(c[r]) : 0.f; c[r] = e; lsum += e; }
                pv_step(L + L_V + (blk >> 1) * 8192, 2 * (blk & 1), pack_p(c, 0), o0, o1, lane);
                pv_step(L + L_V + (blk >> 1) * 8192, 2 * (blk & 1) + 1, pack_p(c, 8), o0, o1, lane);
                if (need_imp) {
#pragma unroll
                    for (int rr = 0; rr < 4; ++rr) { const int j = 8 * blk + 2 * rr + hi; impA[j] = (c[4 * rr] + c[4 * rr + 1]) + (c[4 * rr + 2] + c[4 * rr + 3]); if (j + 1 < 32) impB[j + 1] = c[4 * rr + 3]; }
                }
            } else if (need_imp) {
#pragma unroll
                for (int rr = 0; rr < 4; ++rr) { const int j = 8 * blk + 2 * rr + hi; impA[j] = 0.f; if (j + 1 < 32) impB[j + 1] = 0.f; }
            }
        }
        lsum = xsum(lsum);
        const float inv = lsum > 0.f ? 1.f / lsum : 0.f;
        if (need_imp && hi == 0) { ((LAS float*)(L + L_LINV))[hg * 64 + qq] = inv; impB[0] = 0.f; }
        const float sc = g0 * inv;
#pragma unroll
        for (int r = 0; r < 16; ++r) { acc0[r] = sc * o0[r]; acc1[r] = sc * o1[r]; }
    }
    LAS unsigned* selm = (LAS unsigned*)(L + L_SELM);
    if (need_imp) {
        __syncthreads();
        LAS float* impS = (LAS float*)(L + L_IMPS);
        int tid2 = tid; asm volatile("" : "+v"(tid2));
        { const LAS float* A = (const LAS float*)(L + L_IMPA); const LAS float* Bq = (const LAS float*)(L + L_IMPB); const LAS float* LI = (const LAS float*)(L + L_LINV);
#pragma unroll
          for (int k = 0; k < 4; ++k) { const int idx = tid2 + 512 * k, q2 = idx >> 5, j = idx & 31; float sacc = 0.f;
#pragma unroll
              for (int hh = 0; hh < 4; ++hh) sacc += (A[(hh * 64 + q2) * 33 + j] + Bq[(hh * 64 + q2) * 33 + j]) * LI[hh * 64 + q2];
              impS[q2 * 33 + j] = sacc; } }
        __syncthreads();
        { const int q2 = tid2 >> 3, jg = tid2 & 7; const LAS float* row = impS + q2 * 33; unsigned bits = 0u;
#pragma unroll
          for (int jj = 0; jj < 4; ++jj) { const int j = 4 * jg + jj; bool sel = false;
              if (j == 0 || j == qt || j == qt - 1) sel = true;
              else if (j <= qt - 2) { const float v = row[j]; int rank = 0; for (int j2 = 1; j2 <= qt - 2; ++j2) { const float v2 = row[j2]; rank += (v2 > v || (v2 == v && j2 < j)) ? 1 : 0; } sel = rank < 13; }
              bits |= sel ? (1u << j) : 0u; }
          bits |= __shfl_xor(bits, 1); bits |= __shfl_xor(bits, 2); bits |= __shfl_xor(bits, 4);
          if (jg == 0) selm[q2] = bits; }
        __syncthreads();
    } else {
        if (tid < 64) selm[tid] = (2u << qt) - 1u;
        __syncthreads();
    }
    const unsigned myselm = selm[qq];
    unsigned uni = selm[lane];
#pragma unroll
    for (int o = 32; o > 0; o >>= 1) uni |= __shfl_xor(uni, o);
    uni = __builtin_amdgcn_readfirstlane(uni);
    int buf = 0;
    {
        State st; st.dl = 0.f; st.l = 0.f;
#pragma unroll
        for (int r = 0; r < 16; ++r) { st.o0[r] = 0.f; st.o1[r] = 0.f; }
        tile_loop(uni, myselm, qt, -1, zb, ZC_KSLC + g * 64, ZC_VSLC + g * 64, qr, slope2, tq, qq, st, L, buf, w, lane);
        const float sc = g1 / xsum(st.l);
#pragma unroll
        for (int r = 0; r < 16; ++r) { acc0[r] += sc * st.o0[r]; acc1[r] += sc * st.o1[r]; }
    }
    {
        State st; st.dl = 0.f; st.l = 0.f;
#pragma unroll
        for (int r = 0; r < 16; ++r) { st.o0[r] = 0.f; st.o1[r] = 0.f; }
        const int jlo = max(0, qt - 8); const unsigned tm = ((2u << qt) - 1u) & ~((1u << jlo) - 1u);
        tile_loop(tm, 0xffffffffu, qt, qt - 8, zb, ZC_KWIN + g * 64, ZC_VWIN + g * 64, qr, slope2, tq, qq, st, L, buf, w, lane);
        const float sc = g2 / xsum(st.l);
#pragma unroll
        for (int r = 0; r < 16; ++r) { acc0[r] += sc * st.o0[r]; acc1[r] += sc * st.o1[r]; }
    }
    store_o(oalt ? oalt + ((size_t)b * S_ + tq) * D_ + h * 64 : zrowq + ZC_QN + h * 64, acc0, acc1, hi);
    __syncthreads();
}

__device__ __forceinline__ void moba_unit(bf16_t* Z, const float* kmean, int b, int h, int nb, LAS unsigned char* L, int tid_, bf16_t* oalt) {
    int tid = tid_; asm volatile("" : "+v"(tid));
    const int lane = tid & 63, w = __builtin_amdgcn_readfirstlane(tid >> 6), r32 = lane & 31, hi = lane >> 5;
    const int qq = 32 * (w & 1) + r32, tq = 256 * nb + 32 * w + r32;
    bf16_t* zrowq = Z + ((size_t)b * S_ + tq) * ZP;
    const bf16_t* zb = Z + (size_t)b * S_ * ZP;
    bf16x8 qr[4];
#pragma unroll
    for (int s = 0; s < 4; ++s) qr[s] = *(const bf16x8*)(zrowq + ZC_QM + h * 64 + 16 * s + 8 * hi);
    const float slope2 = exp2f(-(float)(h + 1)) * LOG2E;
    LAS float* km = (LAS float*)(L + L_KMEAN); LAS unsigned* misc = (LAS unsigned*)(L + L_MISC);
    km[tid] = kmean[((size_t)b * 8 + h) * 512 + tid];
    if (tid == 0) misc[1] = 0u;
    __syncthreads();
    unsigned lsel = 0u;
    if (nb > 0) {
        float gs[8];
#pragma unroll
        for (int j = 0; j < 8; ++j) {
            float s = 0.f;
            if (j < nb) {
#pragma unroll
                for (int sI = 0; sI < 4; ++sI) { const u32x4 qw = __builtin_bit_cast(u32x4, qr[sI]); const LAS float* kk = km + j * 64 + 16 * sI + 8 * hi;
                    s += bflo(qw.x) * kk[0] + bfhi(qw.x) * kk[1] + bflo(qw.y) * kk[2] + bfhi(qw.y) * kk[3] + bflo(qw.z) * kk[4] + bfhi(qw.z) * kk[5] + bflo(qw.w) * kk[6] + bfhi(qw.w) * kk[7]; }
                s = xsum(s);
            } else s = -1e30f;
            gs[j] = s;
        }
        unsigned bsel = 0u;
#pragma unroll
        for (int j = 0; j < 8; ++j) { int rank = 0;
#pragma unroll
            for (int j2 = 0; j2 < 8; ++j2) rank += (gs[j2] > gs[j] || (gs[j2] == gs[j] && j2 < j)) ? 1 : 0;
            if (j < nb && rank < 3) bsel |= 1u << j; }
#pragma unroll
        for (int j = 0; j < 8; ++j) if ((bsel >> j) & 1u) lsel |= 0xfu << (4 * j);
        unsigned u = bsel;
#pragma unroll
        for (int o = 32; o > 0; o >>= 1) u |= __shfl_xor(u, o);
        if (lane == 0) (void)__hip_atomic_fetch_or(misc + 1, u, __ATOMIC_RELAXED, __HIP_MEMORY_SCOPE_WORKGROUP);
    }
    __syncthreads();
    unsigned ub = misc[1]; ub = __builtin_amdgcn_readfirstlane(ub);
    unsigned tm = 0xfu << (4 * nb);
#pragma unroll
    for (int j = 0; j < 8; ++j) if ((ub >> j) & 1u) tm |= 0xfu << (4 * j);
    lsel |= 0xfu << (4 * nb);
    State st; st.dl = 0.f; st.l = 0.f;
#pragma unroll
    for (int r = 0; r < 16; ++r) { st.o0[r] = 0.f; st.o1[r] = 0.f; }
    int buf = 0;
    tile_loop(tm, lsel, 4 * nb + (w >> 1), -1, zb, ZC_KM + h * 64, ZC_VM + h * 64, qr, slope2, tq, qq, st, L, buf, w, lane);
    const float sc = 1.f / xsum(st.l);
#pragma unroll
    for (int r = 0; r < 16; ++r) { st.o0[r] *= sc; st.o1[r] *= sc; }
    store_o(oalt ? oalt + ((size_t)b * S_ + tq) * D_ + 512 + h * 64 : zrowq + ZC_QM + h * 64, st.o0, st.o1, hi);
    __syncthreads();
}

__device__ __forceinline__ void attn_phase(bf16_t* Z, const bf16_t* kc, const bf16_t* vc, const float* kmean, unsigned* qhead, LAS unsigned char* L, int tid, bf16_t* oalt) {
    LAS unsigned* misc = (LAS unsigned*)(L + L_MISC);
    for (;;) {
        if (tid == 0) misc[0] = atomicAdd(qhead, 1u);
        __syncthreads();
        int u = (int)misc[0]; u = __builtin_amdgcn_readfirstlane(u);
        __syncthreads();
        if (u >= 1024) break;
        int lv = 31;
        for (;; --lv) { const int cnt = 16 + ((lv & 3) == 3 ? 64 : 0); if (u < cnt) break; u -= cnt; }
        if (u < 16) nsa_unit(Z, kc, vc, u >> 1, u & 1, lv, L, tid, oalt);
        else { u -= 16; moba_unit(Z, kmean, u >> 3, u & 7, lv >> 2, L, tid, oalt); }
    }
}
}
namespace fc {
constexpr int SEGB = 2064;
constexpr int L_A = 0, L_X = 17 * SEGB + 48  , L_H = L_X + 8192  , L_END = L_H + 16 * 132 * 4;
static_assert(L_X % 16 == 0 && L_END <= 131072, "cmp LDS");
__device__ __forceinline__ float gelu_t(float x) { const float u = 0.7978845608028654f * (x + 0.044715f * x * x * x); const float e = __builtin_amdgcn_exp2f(2.f * LOG2E * u); return x * (1.f - __builtin_amdgcn_rcpf(1.f + e)); }
__device__ __forceinline__ void cmp_unit(const Args& a, LAS unsigned char* L, int u, int tid_) {
    int tid = tid_; asm volatile("" : "+v"(tid));
    unsigned char* ws = a.ws; const bf16_t* Z = (const bf16_t*)(ws + WS_R);
    const int lane = tid & 63, w = __builtin_amdgcn_readfirstlane(tid >> 6);
    const int kv = u >> 7, bg = (u >> 3) & 15, grp = u & 7, b = bg >> 1, g = bg & 1;
    const int col = (kv ? ZC_VCMP : ZC_KCMP) + g * 64;
    for (int i = tid; i < 272 * 8; i += NTHR) { const int tt = i >> 3, ch = i & 7; const int tok = min(256 * grp + tt, S_ - 1);
        const u32x4 v = *(const u32x4*)(Z + ((size_t)b * S_ + tok) * ZP + col + ch * 8);
        *(LAS u32x4*)(L + L_A + (tt >> 4) * SEGB + (tt & 15) * 128 + ch * 16) = v; }
    __syncthreads();
    const int half = w >> 2, ns = w & 3, m = lane & 15, kg = lane >> 4;
    const bf16_t* w1t = (const bf16_t*)(ws + (kv ? WS_WC1V : WS_WC1K)) + (size_t)(32 * ns + m) * 2048 + half * 1024 + kg * 8;
    const LAS unsigned char* ab = L + L_A + (m + half) * SEGB + kg * 16;
    f32x4 acc0 = (f32x4){0.f, 0.f, 0.f, 0.f}, acc1 = acc0;
#pragma unroll 4
    for (int kk = 0; kk < 32; ++kk) {
        const bf16x8 af = *(const LAS bf16x8*)(ab + (kk >> 1) * 128 + (kk & 1) * 64);
        const bf16x8 b0 = *(const bf16x8*)(w1t + kk * 32), b1 = *(const bf16x8*)(w1t + 16 * 2048 + kk * 32);
        acc0 = __builtin_amdgcn_mfma_f32_16x16x32_bf16(af, b0, acc0, 0, 0, 0);
        acc1 = __builtin_amdgcn_mfma_f32_16x16x32_bf16(af, b1, acc1, 0, 0, 0);
    }
    LAS float* X = (LAS float*)(L + L_X); LAS float* H = (LAS float*)(L + L_H);
    if (half == 1) {
#pragma unroll
        for (int r = 0; r < 4; ++r) { X[(4 * kg + r) * 128 + 32 * ns + m] = acc0[r]; X[(4 * kg + r) * 128 + 32 * ns + 16 + m] = acc1[r]; }
    }
    __syncthreads();
    if (half == 0) {
        const float* bias = (const float*)(ws + WS_CBIAS) + kv * 128;
        const float bz0 = bias[32 * ns + m], bz1 = bias[32 * ns + 16 + m];
#pragma unroll
        for (int r = 0; r < 4; ++r) { const int sg = 4 * kg + r;
            H[sg * 132 + 32 * ns + m] = gelu_t(acc0[r] + X[sg * 128 + 32 * ns + m] + bz0);
            H[sg * 132 + 32 * ns + 16 + m] = gelu_t(acc1[r] + X[sg * 128 + 32 * ns + 16 + m] + bz1); }
    }
    __syncthreads();
    {
        const int sg = tid >> 5, cp = tid & 31; const float* w2 = a.in[kv ? 13 : 10] + 2 * cp; const LAS float* hr = H + sg * 132; float s0 = 0.f, s1 = 0.f;
#pragma unroll 8
        for (int j = 0; j < 128; ++j) { const f32x2_t wv = *(const f32x2_t*)(w2 + j * 64); const float hv = hr[j]; s0 += hv * wv[0]; s1 += hv * wv[1]; }
        const int c = 16 * grp + sg;
        bf16_t* outc = (bf16_t*)(ws + (kv ? WS_VC : WS_KC)) + ((size_t)bg * 128 + c) * 64 + 2 * cp;
        *(unsigned*)outc = (c == 127) ? 0u : cvtpk(s0, s1);
    }
    __syncthreads();
}
__device__ __forceinline__ void kmean_fast(const Args& a, int gw, int ngw, int lane) {
    const bf16_t* Z = (const bf16_t*)(a.ws + WS_R); float* kmean = (float*)(a.ws + WS_KMEAN);
    for (int it = gw; it < 512; it += ngw) {
        const int n = it & 7, h = (it >> 3) & 7, b = it >> 6, rs = lane >> 3, ch = lane & 7;
        float s[8];
#pragma unroll
        for (int i = 0; i < 8; ++i) s[i] = 0.f;
        const bf16_t* base = Z + ((size_t)b * S_ + 256 * n + rs) * ZP + ZC_KM + h * 64 + ch * 8;
#pragma unroll 4
        for (int i = 0; i < 32; ++i) { const u32x4 v = *(const u32x4*)(base + (size_t)(8 * i) * ZP);
            s[0] += bflo(v.x); s[1] += bfhi(v.x); s[2] += bflo(v.y); s[3] += bfhi(v.y); s[4] += bflo(v.z); s[5] += bfhi(v.z); s[6] += bflo(v.w); s[7] += bfhi(v.w); }
#pragma unroll
        for (int i = 0; i < 8; ++i) { s[i] += __shfl_xor(s[i], 8); s[i] += __shfl_xor(s[i], 16); s[i] += __shfl_xor(s[i], 32); }
        if (rs == 0) { f32x4 o0 = (f32x4){s[0], s[1], s[2], s[3]} * (1.f / 256.f), o1 = (f32x4){s[4], s[5], s[6], s[7]} * (1.f / 256.f);
            *(f32x4*)(kmean + (size_t)it * 64 + ch * 8) = o0; *(f32x4*)(kmean + (size_t)it * 64 + ch * 8 + 4) = o1; }
    }
}
}
constexpr int RING_OFF = 0, RING_BYTES = 131072;
constexpr int MISC_OFF = RING_BYTES;
constexpr int LDS_BYTES = 147456;
constexpr int N_PHASES = 12;

__global__ void __launch_bounds__(NTHR, 2) mega(Args args) {
    extern __shared__ __attribute__((aligned(16))) unsigned char lds_raw[];
    LAS unsigned char* lds = (LAS unsigned char*)lds_raw;
    const int tid = threadIdx.x, lane = tid & 63, wave = __builtin_amdgcn_readfirstlane(tid >> 6);
    const int G = gridDim.x, bx = blockIdx.x;
    const int vcu = (G % 8 == 0) ? (bx % 8) * (G / 8) + bx / 8 : bx;
    volatile LAS unsigned* MISC = (volatile LAS unsigned*)(lds + MISC_OFF);
    if (tid < 32) MISC[tid] = 0u;
    __syncthreads();
    unsigned char* ws = args.ws;
    const int lo = args.ph_lo, hi = args.ph_hi;
    XcdBarrier bar; bar.bar = (unsigned*)(ws + WS_CTL) + CW_BAR; bar.x = 0; bar.st = MISC + 8;
    if (hi - lo > 1) bar = xcd_barrier_post((unsigned*)(ws + WS_CTL) + CW_BAR, MISC + 8);
#define IN(k) (lo <= (k) && (k) < hi)
#define SEAM(k) do { if (IN(k) && IN((k) + 1)) xcd_barrier(bar); } while (0)
    float* out = args.out;
    bf16_t* AB = (bf16_t*)(ws + WS_AB); bf16_t* AB2 = (bf16_t*)(ws + WS_AB2); bf16_t* HID = (bf16_t*)(ws + WS_R); bf16_t* Z = (bf16_t*)(ws + WS_R); float* PE = (float*)(ws + WS_R);
    float* SS1 = (float*)(ws + WS_SS); float* SS2 = (float*)(ws + WS_SS + SZ_SS); float* SS3 = (float*)(ws + WS_SS + 2 * SZ_SS); float* SS4 = (float*)(ws + WS_SS + 3 * SZ_SS); float* SS5 = (float*)(ws + WS_SS + 4 * SZ_SS);

    if (IN(0)) { p0_prologue(args, lds, vcu, G, wave, lane, tid);
#if PROBE_DUP == 0
        p0_prologue(args, lds, vcu, G, wave, lane, tid);
#endif
        SEAM(0); }
    if (IN(1)) { pg8::Gemm g{AB, (const bf16_t*)(ws + WS_W13A), D_, D_, M_, 2 * F_, D_}; pg8::StaticOrder S; S.init(M_, 2 * F_, G, bx);
        pg8::EpiSwiglu E{SS1, HID}; pg8::gemm_phase<pg8::EpiSwiglu, pg8::StaticOrder, true>(lds + RING_OFF, g, S, E);
#if PROBE_DUP == 1
        pg8::gemm_phase<pg8::EpiSwiglu, pg8::StaticOrder, true>(lds + RING_OFF, g, S, E);
#endif
        SEAM(1); }
    if (IN(2)) { pg8::Gemm g{HID, (const bf16_t*)(ws + WS_W2A), F_, F_, M_, D_, F_}; pg8::StaticOrder S; S.init(M_, D_, G, bx);
        pg8::EpiRes E{args.in[0], out, AB, SS2, 0.5f}; pg8::gemm_phase<pg8::EpiRes, pg8::StaticOrder, false>(lds + RING_OFF, g, S, E);
#if PROBE_DUP == 2
        pg8::gemm_phase<pg8::EpiRes, pg8::StaticOrder, false>(lds + RING_OFF, g, S, E);
#endif
        SEAM(2); }
    if (IN(3)) { pg8::Gemm g{AB, (const bf16_t*)(ws + WS_WIN), D_, D_, M_, NINP, D_}; pg8::StaticOrder S; S.init(M_, NINP, G, bx);
        pg8::EpiInproj E{SS2, Z}; pg8::gemm_phase<pg8::EpiInproj, pg8::StaticOrder, true>(lds + RING_OFF, g, S, E);
#if PROBE_DUP == 3
        pg8::gemm_phase<pg8::EpiInproj, pg8::StaticOrder, true>(lds + RING_OFF, g, S, E);
#endif
        SEAM(3); }
    if (IN(4)) {
#if defined(CMP_GOLDEN)
        cmp_phase_simple(args, lds, vcu, G, tid); kmean_phase_simple(args, vcu, G, wave, lane);
#else
        for (int u = vcu; u < 256; u += G) fc::cmp_unit(args, lds, u, tid);
        fc::kmean_fast(args, vcu * NWAVES + wave, G * NWAVES, lane);
#if PROBE_DUP == 4
        for (int u = vcu; u < 256; u += G) fc::cmp_unit(args, lds, u, tid);
        fc::kmean_fast(args, vcu * NWAVES + wave, G * NWAVES, lane);
#endif
#endif
        SEAM(4); }
    if (IN(5)) {
        const bf16_t* kc = (const bf16_t*)(ws + WS_KC); const bf16_t* vc = (const bf16_t*)(ws + WS_VC); const float* kmean = (const float*)(ws + WS_KMEAN);
#if defined(ATTN_GOLDEN)
        for (int it = vcu; it < M_; it += G) { nsa_item_simple(Z, kc, vc, it >> 11, it & 2047, (LAS float*)lds, tid); moba_item_simple(Z, kmean, it >> 11, it & 2047, (LAS float*)lds, tid); }
#else
#if PROBE_DUP == 5
        fa::attn_phase(Z, kc, vc, kmean, (unsigned*)(ws + WS_CTL) + CW_QUEUE + 64, lds, tid, AB);
#endif
        fa::attn_phase(Z, kc, vc, kmean, (unsigned*)(ws + WS_CTL) + CW_QUEUE, lds, tid, nullptr);
#endif
        SEAM(5); }
    if (IN(6)) {
        { pg8::Gemm g{Z + ZC_QN, (const bf16_t*)(ws + WS_WUPN), ZP, 512, M_, D_, 512}; pg8::StaticOrder S; S.init(M_, D_, G, bx);
          pg8::EpiUpmix<0> E{Z, AB}; pg8::gemm_phase<pg8::EpiUpmix<0>, pg8::StaticOrder, false>(lds + RING_OFF, g, S, E); }
        { pg8::Gemm g{Z + ZC_QM, (const bf16_t*)(ws + WS_WUPM), ZP, 512, M_, D_, 512}; pg8::StaticOrder S; S.init(M_, D_, G, bx);
          pg8::EpiUpmix<1> E{Z, AB}; pg8::gemm_phase<pg8::EpiUpmix<1>, pg8::StaticOrder, false>(lds + RING_OFF, g, S, E); }
        SEAM(6); }
    if (IN(7)) { pg8::Gemm g{AB, (const bf16_t*)(ws + WS_WOUT), D_, D_, M_, D_, D_}; pg8::StaticOrder S; S.init(M_, D_, G, bx);
        pg8::EpiRes E{out, out, AB2, SS3, 1.0f}; pg8::gemm_phase<pg8::EpiRes, pg8::StaticOrder, false>(lds + RING_OFF, g, S, E); SEAM(7); }
    if (IN(8)) { pg8::Gemm g{AB2, (const bf16_t*)(ws + WS_W13B), D_, D_, M_, 2 * F_, D_}; pg8::StaticOrder S; S.init(M_, 2 * F_, G, bx);
        pg8::EpiSwiglu E{SS3, HID}; pg8::gemm_phase<pg8::EpiSwiglu, pg8::StaticOrder, true>(lds + RING_OFF, g, S, E); SEAM(8); }
    if (IN(9)) { pg8::Gemm g{HID, (const bf16_t*)(ws + WS_W2B), F_, F_, M_, D_, F_}; pg8::StaticOrder S; S.init(M_, D_, G, bx);
        pg8::EpiRes E{out, out, AB, SS4, 0.5f}; pg8::gemm_phase<pg8::EpiRes, pg8::StaticOrder, false>(lds + RING_OFF, g, S, E); SEAM(9); }
    if (IN(10)) {
        { pg8::Gemm g{(const bf16_t*)(ws + WS_PB), (const bf16_t*)(ws + WS_WPLE), PLE_, PLE_, M_, D_, PLE_}; pg8::StaticOrder S; S.init(M_, D_, G, bx);
          pg8::EpiPe E{PE}; pg8::gemm_phase<pg8::EpiPe, pg8::StaticOrder, false>(lds + RING_OFF, g, S, E); }
        { pg8::Gemm g{AB, (const bf16_t*)(ws + WS_WPG), D_, D_, M_, D_, D_}; pg8::StaticOrder S; S.init(M_, D_, G, bx);
          pg8::EpiPle E{SS4, PE, out, SS5}; pg8::gemm_phase<pg8::EpiPle, pg8::StaticOrder, false>(lds + RING_OFF, g, S, E); }
        SEAM(10); }
    if (IN(11)) {
        const f32x4* gn = (const f32x4*)args.in[24] + lane;
        for (int row = vcu * NWAVES + wave; row < M_; row += G * NWAVES) {
            const float rs = pg8::rs_from_ss(SS5, row, lane >> 4);
            f32x4* hr = (f32x4*)(out + (size_t)row * D_) + lane;
#pragma unroll
            for (int j = 0; j < 4; ++j) { f32x4 v = hr[64 * j]; const f32x4 gg = gn[64 * j]; v = v * gg * rs; hr[64 * j] = v; }
        }
    }
#undef IN
#undef SEAM
}
}

extern "C" void kernel_launch(void* const* d_in, const int* in_sizes, int n_in, void* d_out, int out_size, void* d_ws, size_t ws_size, hipStream_t stream) {
    static int grid = 0;
    if (grid == 0) {
        if (n_in != 25 || ws_size < WS_END || out_size != M_ * D_) { fprintf(stderr, "kernel_launch: unexpected n_in %d / out_size %d / ws_size %zu (need %zu)\n", n_in, out_size, ws_size, (size_t)WS_END); grid = -1; return; }
        int dev = 0, cus = 0, per_cu = 0;
        if (hipGetDevice(&dev) != hipSuccess || hipDeviceGetAttribute(&cus, hipDeviceAttributeMultiprocessorCount, dev) != hipSuccess) { grid = -1; return; }
        if (hipFuncSetAttribute((const void*)mega, hipFuncAttributeMaxDynamicSharedMemorySize, LDS_BYTES) != hipSuccess) { fprintf(stderr, "kernel_launch: hipFuncSetAttribute failed\n"); grid = -1; return; }
        if (hipOccupancyMaxActiveBlocksPerMultiprocessor(&per_cu, (const void*)mega, NTHR, LDS_BYTES) != hipSuccess || per_cu < 1) fprintf(stderr, "kernel_launch: occupancy query reports %d\n", per_cu);
        (void)hipGetLastError();
        grid = cus;
    }
    if (grid < 0) return;
    (void)hipMemsetAsync((char*)d_ws + WS_CTL, 0, CTL_ZERO_BYTES, stream);
    Args a{};
    for (int i = 0; i < 25; ++i) a.in[i] = (const float*)d_in[i];
    a.out = (float*)d_out; a.ws = (unsigned char*)d_ws;
#if MK_N_LAUNCHES == 1
    a.ph_lo = 0; a.ph_hi = N_PHASES;
    hipLaunchKernelGGL(mega, dim3(grid), dim3(NTHR), LDS_BYTES, stream, a);
#else
    for (int k = 0; k < N_PHASES; ++k) { a.ph_lo = k; a.ph_hi = k + 1; hipLaunchKernelGGL(mega, dim3(grid), dim3(NTHR), LDS_BYTES, stream, a); }
#endif
}
```
